# Optimizing an MI355X kernel written in HIP

```python
import math
import jax, jax.numpy as jnp
from jax import lax
import numpy as np

D_MODEL = 1024
BATCH = 16
SEQ = 2048
DEPTH = 2

N_MIXERS = 2
EXPAND = 2
D_INNER = EXPAND * D_MODEL
POOL_WINDOWS = (2, 4, 8, 16)
N_POOL_GROUPS = len(POOL_WINDOWS)
POOL_GROUP_DIM = D_INNER // N_POOL_GROUPS
SB_HEADS = 16
SB_QK_DIM = 64
SB_V_DIM = D_INNER // SB_HEADS
SB_QK_WIDTH = SB_HEADS * SB_QK_DIM
Q_BLOCK = 128
RMS_EPS = 1e-6
N_POOL_LAYERS = (DEPTH + 1) // 2
N_SB_LAYERS = DEPTH // 2

kernel_name = "hybrid_pool_stickbreaking_trunk"


def rms_norm(x, g):
    x32 = x.astype(jnp.float32)
    inv = lax.rsqrt(jnp.mean(x32 * x32, axis=-1, keepdims=True) + RMS_EPS)
    return (x32 * inv * g.astype(jnp.float32)).astype(x.dtype)


def causal_pool_minus_self(u, window):
    S = u.shape[1]
    u32 = u.astype(jnp.float32)
    c = jnp.cumsum(u32, axis=1)
    c_shift = jnp.pad(c, ((0, 0), (window, 0), (0, 0)))[:, :S]
    count = jnp.minimum(jnp.arange(S) + 1, window).astype(jnp.float32)
    mean = (c - c_shift) / count[None, :, None]
    return (mean - u32).astype(u.dtype)


def pooling_mixer(u, w_in, w_group, scale, w_out):
    B, S, _ = u.shape
    proj = u @ w_in
    xb, z = jnp.split(proj, 2, axis=-1)
    xg = xb.reshape(B, S, N_POOL_GROUPS, POOL_GROUP_DIM)
    pooled = jnp.stack(
        [causal_pool_minus_self(xg[:, :, gi], w) for gi, w in enumerate(POOL_WINDOWS)],
        axis=2)
    mixed = jnp.einsum('bsgi,gio->bsgo', pooled, w_group).reshape(B, S, D_INNER)
    y = mixed * scale * jax.nn.silu(z)
    return y @ w_out


def stick_breaking_attention(q, k, v):
    S = q.shape[2]
    scale = 1.0 / math.sqrt(q.shape[-1])
    n_blocks = S // Q_BLOCK
    outs = []
    for bi in range(n_blocks):
        q_lo = bi * Q_BLOCK
        k_len = q_lo + Q_BLOCK
        qb = q[:, :, q_lo:q_lo + Q_BLOCK].astype(jnp.float32)
        kb = k[:, :, :k_len].astype(jnp.float32)
        vb = v[:, :, :k_len].astype(jnp.float32)
        z = jnp.einsum('bhqd,bhkd->bhqk', qb, kb) * scale
        q_pos = q_lo + jnp.arange(Q_BLOCK)
        k_pos = jnp.arange(k_len)
        mask = k_pos[None, :] < q_pos[:, None]
        log_beta = jax.nn.log_sigmoid(z)
        log_om = jnp.where(mask, jax.nn.log_sigmoid(-z), 0.0)
        later = lax.cumsum(log_om, axis=3, reverse=True) - log_om
        a = jnp.where(mask, jnp.exp(log_beta + later), 0.0)
        outs.append(jnp.einsum('bhqk,bhkd->bhqd', a, vb))
    return jnp.concatenate(outs, axis=2).astype(v.dtype)


def stick_breaking_mixer(u, w_in, w_out):
    B, S, _ = u.shape
    proj = u @ w_in
    q, k, v, z = jnp.split(
        proj, [SB_QK_WIDTH, 2 * SB_QK_WIDTH, 2 * SB_QK_WIDTH + D_INNER], axis=-1)
    q = q.reshape(B, S, SB_HEADS, SB_QK_DIM).transpose(0, 2, 1, 3)
    k = k.reshape(B, S, SB_HEADS, SB_QK_DIM).transpose(0, 2, 1, 3)
    v = v.reshape(B, S, SB_HEADS, SB_V_DIM).transpose(0, 2, 1, 3)
    o = stick_breaking_attention(q, k, v)
    o = o.transpose(0, 2, 1, 3).reshape(B, S, D_INNER)
    y = o * jax.nn.silu(z)
    return y @ w_out


def setup_inputs(seed: int = 0) -> dict:
    key = jax.random.key(seed)
    ks = jax.random.split(key, 10)
    f32 = jnp.float32
    x = jax.random.normal(ks[0], (BATCH, SEQ, D_MODEL), f32)
    norm_g = 1.0 + 0.02 * jax.random.normal(ks[1], (DEPTH, D_MODEL), f32)
    pool_w_in = jax.random.normal(ks[2], (N_POOL_LAYERS, D_MODEL, 2 * D_INNER), f32) * D_MODEL ** -0.5
    pool_w = jax.random.normal(ks[3], (N_POOL_LAYERS, N_POOL_GROUPS, POOL_GROUP_DIM, POOL_GROUP_DIM), f32) * POOL_GROUP_DIM ** -0.5
    pool_scale = 1.0 + 0.02 * jax.random.normal(ks[4], (N_POOL_LAYERS, D_INNER), f32)
    pool_w_out = jax.random.normal(ks[5], (N_POOL_LAYERS, D_INNER, D_MODEL), f32) * D_INNER ** -0.5
    sb_w_in = jax.random.normal(ks[6], (N_SB_LAYERS, D_MODEL, 2 * SB_QK_WIDTH + 2 * D_INNER), f32) * D_MODEL ** -0.5
    sb_w_out = jax.random.normal(ks[7], (N_SB_LAYERS, D_INNER, D_MODEL), f32) * D_INNER ** -0.5
    norm_f = 1.0 + 0.02 * jax.random.normal(ks[8], (D_MODEL,), f32)
    return {"x": x, "norm_g": norm_g, "pool_w_in": pool_w_in, "pool_w": pool_w,
            "pool_scale": pool_scale, "pool_w_out": pool_w_out, "sb_w_in": sb_w_in,
            "sb_w_out": sb_w_out, "norm_f": norm_f}


def reference(x, norm_g, pool_w_in, pool_w, pool_scale, pool_w_out, sb_w_in, sb_w_out, norm_f):
    h = x
    for i in range(DEPTH):
        u = rms_norm(h, norm_g[i])
        j = i // N_MIXERS
        if i % N_MIXERS == 0:
            h = h + pooling_mixer(u, pool_w_in[j], pool_w[j], pool_scale[j], pool_w_out[j])
        else:
            h = h + stick_breaking_mixer(u, sb_w_in[j], sb_w_out[j])
    return rms_norm(h, norm_f)
```

```cpp
#include <hip/hip_runtime.h>
#include <hip/hip_cooperative_groups.h>
#include <cstdio>
#include <cstdint>
namespace cg = cooperative_groups;
namespace pg8 {
#define PG8_LAS __attribute__((address_space(3)))
typedef unsigned short bf16_t;
typedef short bf16x8 __attribute__((ext_vector_type(8)));
typedef float f32x4 __attribute__((ext_vector_type(4)));
typedef unsigned u32x4 __attribute__((ext_vector_type(4)));
constexpr int BM = 256, BK = 64, HALF = 128, HTB = HALF * BK * 2  , STAGE_BYTES = 8 * HTB, NXCD = 8, WGM = 8;

__host__ __device__ __forceinline__ int lds_byte(int r, int c) { const int st = (r >> 4) * 2 + (c >> 5), rr = r & 15, cc = c & 31, ob = rr * 64 + cc * 2; return st * 1024 + (ob ^ (((ob >> 9) & 1) << 5)); }
__host__ __device__ __forceinline__ void stage_rc(int b, int& R, int& C) { const int st = b / 1024, sb = b % 1024, swz = sb ^ (((sb >> 9) & 1) << 5); R = (st >> 1) * 16 + swz / 64; C = (st & 1) * 32 + (swz % 64) / 2; }
__host__ __device__ __forceinline__ int perm32(int rho) { const int n = rho >> 4, i = rho & 15; return 8 * (i >> 2) + 4 * n + (i & 3); }

struct Unit { int pm, pn; };
struct Gemm { const bf16_t* A; const bf16_t* Bt; int M, N, K; int gshift; size_t gstride; };

struct StaticOrder {
    int nM, nN, nwg, G, c;
    __host__ __device__ void init(int M, int N, int G_, int c_) { nM = M / BM; nN = N / BM; nwg = nM * nN; G = G_; c = c_; }
    __host__ __device__ bool next(int i, Unit& u) const {
        const long L = (long)i * G + c; if (L >= nwg) return false;
        int wgid = (int)L; { const int q = nwg / NXCD, r = nwg % NXCD, xcd = wgid % NXCD, off = wgid / NXCD; wgid = (xcd < r ? xcd * (q + 1) : r * (q + 1) + (xcd - r) * q) + off; }
        const int nig = WGM * nN, gid = wgid / nig, fm = gid * WGM, gsz = (nM - fm) < WGM ? (nM - fm) : WGM;
        u.pm = fm + ((wgid % nig) % gsz); u.pn = (wgid % nig) / gsz; return true;
    }
    __device__ __forceinline__ void a_ready(const Unit&) const {}
    __device__ __forceinline__ void done(const Unit&) const {}
};

__device__ __forceinline__ unsigned cvt_pk_bf16(float lo, float hi) { unsigned r; asm volatile("v_cvt_pk_bf16_f32 %0, %1, %2" : "=v"(r) : "v"(lo), "v"(hi)); return r; }

template <class Epi, class Sched, bool ALIGN_EPI = false, bool SP2 = false>
__device__ __forceinline__ void gemm_phase(PG8_LAS unsigned char* lds, const Gemm g, const Sched& S, const Epi& E) {
    const int tid = threadIdx.x, wid = __builtin_amdgcn_readfirstlane(tid >> 6), lane = tid & 63, wr = wid >> 2, wc = wid & 3, fr = lane & 15, fq = lane >> 4;
    const int K = g.K, nt = K / BK;
    unsigned voffA[2], voffB[2];
#pragma unroll
    for (int i = 0; i < 2; ++i) { int R, C; stage_rc(tid * 16 + i * 8192, R, C); const int Rb = Epi::PERM ? ((R & ~31) + perm32(R & 31)) : R;
        voffA[i] = (unsigned)(R * K + C) * 2u; voffB[i] = (unsigned)(Rb * K + C) * 2u; }
    const size_t kstep = (size_t)(BK * 2);
    const size_t hstep = (size_t)HALF * K * 2;
    const size_t tstep = 2 * hstep;
    const unsigned ldsw = (unsigned)wid * 1024u;
    const int aoff = lds_byte(wr * 64 + fr, fq * 8), boff = lds_byte(wc * 32 + fr, fq * 8);
#define PG8_SA(b, h) (((b) * 2 + (h)) * HTB)
#define PG8_SB(b, h) ((4 + (b) * 2 + (h)) * HTB)
#define PG8_STAGE(bufoff, gbase, voff) do { _Pragma("unroll") for (int _i = 0; _i < 2; ++_i) \
        __builtin_amdgcn_global_load_lds((const unsigned*)((const char*)(gbase) + (voff)[_i]), (PG8_LAS unsigned*)(lds + (bufoff) + ldsw + _i * 8192), 16, 0, 0); } while (0)
#define PG8_LDA(dst, b, h) do { _Pragma("unroll") for (int m = 0; m < 4; ++m) _Pragma("unroll") for (int k = 0; k < 2; ++k) dst[m][k] = *(const PG8_LAS bf16x8*)(lds + PG8_SA(b, h) + aoff + m * 2048 + k * 1024); } while (0)
#define PG8_LDB(dst, b, h) do { _Pragma("unroll") for (int n = 0; n < 2; ++n) _Pragma("unroll") for (int k = 0; k < 2; ++k) dst[n][k] = *(const PG8_LAS bf16x8*)(lds + PG8_SB(b, h) + boff + n * 2048 + k * 1024); } while (0)
#define PG8_MMA(ai, bj, At, Bt) do { __builtin_amdgcn_s_setprio(1); _Pragma("unroll") for (int m = 0; m < 4; ++m) _Pragma("unroll") for (int n = 0; n < 2; ++n) _Pragma("unroll") for (int k = 0; k < 2; ++k) \
        acc[ai][bj][m][n] = __builtin_amdgcn_mfma_f32_16x16x32_bf16(Bt[n][k], At[m][k], acc[ai][bj][m][n], 0, 0, 0); __builtin_amdgcn_s_setprio(0); } while (0)
#define PG8_WAIT_V(n) asm volatile("s_waitcnt vmcnt(" #n ")" ::: "memory")
#define PG8_WAIT_L(n) asm volatile("s_waitcnt lgkmcnt(" #n ")" ::: "memory")
#define PG8_BAR __builtin_amdgcn_s_barrier()
#define PG8_SCHED __builtin_amdgcn_sched_barrier(0)
    Unit cur, nxt; int ui = 0;
    if (!S.next(0, cur)) return;
    f32x4 acc[2][2][4][2];
#pragma unroll
    for (int a = 0; a < 2; ++a)
#pragma unroll
        for (int b = 0; b < 2; ++b)
#pragma unroll
            for (int m = 0; m < 4; ++m)
#pragma unroll
                for (int n = 0; n < 2; ++n) acc[a][b][m][n] = (f32x4){0.f, 0.f, 0.f, 0.f};
    bf16x8 At[4][2], B0[2][2], B1[2][2];
    const char* cA = (const char*)g.A + (size_t)cur.pm * tstep; const char* cB = (const char*)g.Bt + (size_t)(cur.pm >> g.gshift) * g.gstride + (size_t)cur.pn * tstep;
    S.a_ready(cur);
    if constexpr (SP2) {
        PG8_STAGE(PG8_SB(0, 0), cB, voffB); PG8_STAGE(PG8_SB(0, 1), cB + hstep, voffB); PG8_STAGE(PG8_SA(0, 0), cA, voffA); PG8_STAGE(PG8_SA(0, 1), cA + hstep, voffA);
        if (wr == 1) PG8_BAR;
        PG8_WAIT_V(2); PG8_BAR;
        PG8_STAGE(PG8_SB(1, 0), cB + kstep, voffB); PG8_STAGE(PG8_SA(1, 0), cA + kstep, voffA); PG8_STAGE(PG8_SB(1, 1), cB + hstep + kstep, voffB);
        PG8_WAIT_V(6); PG8_BAR;
    } else {
        PG8_STAGE(PG8_SB(0, 0), cB, voffB); PG8_STAGE(PG8_SA(0, 0), cA, voffA); PG8_STAGE(PG8_SB(0, 1), cB + hstep, voffB); PG8_STAGE(PG8_SA(0, 1), cA + hstep, voffA);
        if (wr == 1) PG8_BAR;
        PG8_WAIT_V(4); PG8_BAR;
        PG8_STAGE(PG8_SB(1, 0), cB + kstep, voffB); PG8_STAGE(PG8_SA(1, 0), cA + kstep, voffA); PG8_STAGE(PG8_SB(1, 1), cB + hstep + kstep, voffB);
        PG8_WAIT_V(6); PG8_BAR;
    }
    for (;;) {
        const bool has_next = S.next(ui + 1, nxt);
        const char* nA = has_next ? (const char*)g.A + (size_t)nxt.pm * tstep : cA; const char* nB = has_next ? (const char*)g.Bt + (size_t)(nxt.pm >> g.gshift) * g.gstride + (size_t)nxt.pn * tstep : cB;
        for (int t = 0; t < nt; t += 2) {
            const bool last = (t == nt - 2);
            const char* a1 = cA + (size_t)(t + 1) * kstep;
            const char* a2 = last ? nA : cA + (size_t)(t + 2) * kstep; const char* b2 = last ? nB : cB + (size_t)(t + 2) * kstep;
            const char* a3 = a2 + kstep; const char* b3 = b2 + kstep;
            if (last && has_next) S.a_ready(nxt);
            if constexpr (SP2) {
            PG8_LDB(B0, 0, 0); PG8_LDB(B1, 0, 1); PG8_SCHED; PG8_LDA(At, 0, 0); PG8_STAGE(PG8_SA(1, 1), a1 + hstep, voffA);
            PG8_WAIT_V(8); PG8_WAIT_L(0); PG8_BAR; PG8_MMA(0, 0, At, B0); PG8_MMA(0, 1, At, B1); PG8_BAR; PG8_SCHED;
            PG8_LDA(At, 0, 1); PG8_STAGE(PG8_SB(0, 0), b2, voffB); PG8_STAGE(PG8_SB(0, 1), b2 + hstep, voffB); PG8_STAGE(PG8_SA(0, 0), a2, voffA);
            PG8_WAIT_V(8); PG8_WAIT_L(0); PG8_BAR; PG8_MMA(1, 0, At, B0); PG8_MMA(1, 1, At, B1); PG8_BAR; PG8_SCHED;
            PG8_LDB(B0, 1, 0); PG8_LDB(B1, 1, 1); PG8_SCHED; PG8_LDA(At, 1, 0); PG8_STAGE(PG8_SA(0, 1), a2 + hstep, voffA);
            PG8_WAIT_V(8); PG8_WAIT_L(0); PG8_BAR; PG8_MMA(0, 0, At, B0); PG8_MMA(0, 1, At, B1); PG8_BAR; PG8_SCHED;
            PG8_LDA(At, 1, 1); PG8_STAGE(PG8_SB(1, 0), b3, voffB); PG8_STAGE(PG8_SB(1, 1), b3 + hstep, voffB); PG8_STAGE(PG8_SA(1, 0), a3, voffA);
            PG8_WAIT_V(8); PG8_WAIT_L(0); PG8_BAR; PG8_MMA(1, 0, At, B0); PG8_MMA(1, 1, At, B1); PG8_BAR; PG8_SCHED;
            } else {
            PG8_LDB(B0, 0, 0); PG8_SCHED; PG8_LDA(At, 0, 0); PG8_STAGE(PG8_SA(1, 1), a1 + hstep, voffA);
            PG8_WAIT_L(8); PG8_BAR; PG8_WAIT_L(0); PG8_MMA(0, 0, At, B0); PG8_BAR; PG8_SCHED;
            PG8_LDB(B1, 0, 1); PG8_STAGE(PG8_SB(0, 0), b2, voffB);
            PG8_BAR; PG8_WAIT_L(0); PG8_MMA(0, 1, At, B1); PG8_BAR;
            PG8_LDA(At, 0, 1); PG8_STAGE(PG8_SA(0, 0), a2, voffA);
            PG8_BAR; PG8_WAIT_L(0); PG8_MMA(1, 0, At, B0); PG8_BAR; PG8_SCHED;
            PG8_STAGE(PG8_SB(0, 1), b2 + hstep, voffB);
            PG8_WAIT_V(6); PG8_BAR; PG8_MMA(1, 1, At, B1); PG8_BAR;
            PG8_LDB(B0, 1, 0); PG8_SCHED; PG8_LDA(At, 1, 0); PG8_STAGE(PG8_SA(0, 1), a2 + hstep, voffA);
            PG8_WAIT_L(8); PG8_BAR; PG8_WAIT_L(0); PG8_MMA(0, 0, At, B0); PG8_BAR; PG8_SCHED;
            PG8_LDB(B1, 1, 1); PG8_STAGE(PG8_SB(1, 0), b3, voffB);
            PG8_BAR; PG8_WAIT_L(0); PG8_MMA(0, 1, At, B1); PG8_BAR;
            PG8_LDA(At, 1, 1); PG8_STAGE(PG8_SA(1, 0), a3, voffA);
            PG8_BAR; PG8_WAIT_L(0); PG8_MMA(1, 0, At, B0); PG8_BAR; PG8_SCHED;
            PG8_STAGE(PG8_SB(1, 1), b3 + hstep, voffB);
            PG8_WAIT_V(6); PG8_BAR; PG8_MMA(1, 1, At, B1); PG8_BAR;
            }
        }
        if constexpr (ALIGN_EPI) { if (wr == 0) PG8_BAR; }
        if constexpr (!Epi::AFTER_DRAIN) { E(acc, cur, wr, wc, fr, fq); S.done(cur); }
        if (!has_next) break;
#pragma unroll
        for (int a = 0; a < 2; ++a)
#pragma unroll
            for (int b = 0; b < 2; ++b)
#pragma unroll
                for (int m = 0; m < 4; ++m)
#pragma unroll
                    for (int n = 0; n < 2; ++n) acc[a][b][m][n] = (f32x4){0.f, 0.f, 0.f, 0.f};
        cur = nxt; cA = nA; cB = nB; ++ui;
        if constexpr (ALIGN_EPI) { if (wr == 1) PG8_BAR; }
    }
    PG8_WAIT_V(0);
    if constexpr (!ALIGN_EPI) { if (wr == 0) PG8_BAR; }
    PG8_BAR;
    if constexpr (Epi::AFTER_DRAIN) { E.fused(acc, cur, wr, wc, fr, fq, lds, wid, lane); S.done(cur); }
#undef PG8_SA
#undef PG8_SB
#undef PG8_STAGE
#undef PG8_LDA
#undef PG8_LDB
#undef PG8_MMA
#undef PG8_WAIT_V
#undef PG8_WAIT_L
#undef PG8_BAR
#undef PG8_SCHED
}
}

#ifndef MK_SPLIT
#define MK_SPLIT 0
#endif
constexpr int DM = 1024, BATCH = 16, SEQ = 2048, MTOK = BATCH * SEQ, DI = 2048, NH = 16, DK = 64, DV = 128;
constexpr float RMS_EPS = 1e-6f;
constexpr float QSCALE = 0.125f * 1.4426950408889634f;
constexpr int NPHASE = 9;
constexpr size_t MiB = 1u << 20;
constexpr size_t WS_W0T = 0;
constexpr size_t WS_W0OT = 8 * MiB;
constexpr size_t WS_W1T = 12 * MiB;
constexpr size_t WS_W1OT = 24 * MiB;
constexpr size_t WS_FA = 28 * MiB;
constexpr size_t WS_FB = 30 * MiB;
constexpr size_t WS_INV0 = 34 * MiB;
constexpr size_t WS_SSQ1 = 35 * MiB;
constexpr size_t WS_SSQ2 = 37 * MiB;
constexpr size_t WS_XB = 40 * MiB;
constexpr size_t WS_A = 104 * MiB;
constexpr size_t WS_B = 232 * MiB;
constexpr size_t WS_C = 360 * MiB;
constexpr size_t WS_END = 488 * MiB;
constexpr int LDS_BYTES = 147456;

#define LAS __attribute__((address_space(3)))
typedef unsigned short bf16_t;
typedef short bf16x8 __attribute__((ext_vector_type(8)));
typedef float f32x4 __attribute__((ext_vector_type(4)));
typedef float f32x16 __attribute__((ext_vector_type(16)));
typedef unsigned u32x4 __attribute__((ext_vector_type(4)));
typedef unsigned u32x2 __attribute__((ext_vector_type(2)));
using pg8::cvt_pk_bf16;
#define LDS_WAIT() asm volatile("s_waitcnt lgkmcnt(0)" ::: "memory")

__device__ __forceinline__ float bf_lo(unsigned w) { return __uint_as_float(w << 16); }
__device__ __forceinline__ float bf_hi(unsigned w) { return __uint_as_float(w & 0xffff0000u); }
__device__ __forceinline__ float silu_f(float v) { return v * __builtin_amdgcn_rcpf(1.0f + __builtin_amdgcn_exp2f(-1.4426950408889634f * v)); }
__device__ __forceinline__ float wave_sum(float v) {
#pragma unroll
    for (int o = 1; o < 64; o <<= 1) v += __shfl_xor(v, o);
    return v;
}

struct EpiStore {
    static constexpr bool PERM = true, AFTER_DRAIN = false;
    bf16_t* O; int ldc;
    __device__ __forceinline__ void operator()(const f32x4 (&acc)[2][2][4][2], const pg8::Unit& u, int wr, int wc, int fr, int fq) const {
        const int row0 = u.pm * 256 + wr * 64 + fr, col0 = u.pn * 256 + wc * 32 + 8 * fq;
#pragma unroll
        for (int ai = 0; ai < 2; ++ai)
#pragma unroll
            for (int m = 0; m < 4; ++m) { bf16_t* rowp = O + (size_t)(row0 + ai * 128 + m * 16) * ldc + col0;
#pragma unroll
                for (int bj = 0; bj < 2; ++bj) { const f32x4 v0 = acc[ai][bj][m][0], v1 = acc[ai][bj][m][1]; u32x4 w;
                    w.x = cvt_pk_bf16(v0[0], v0[1]); w.y = cvt_pk_bf16(v0[2], v0[3]); w.z = cvt_pk_bf16(v1[0], v1[1]); w.w = cvt_pk_bf16(v1[2], v1[3]);
                    *(u32x4*)(rowp + bj * 128) = w; } }
    }
};
struct EpiG1 {
    static constexpr bool PERM = true, AFTER_DRAIN = false;
    const float* inv; bf16_t* XM; bf16_t* SZ;
    __device__ __forceinline__ void operator()(const f32x4 (&acc)[2][2][4][2], const pg8::Unit& u, int wr, int wc, int fr, int fq) const {
        const int row0 = u.pm * 256 + wr * 64 + fr; const bool gate = u.pn >= 8;
        const int col0 = (u.pn & 7) * 256 + wc * 32 + 8 * fq; bf16_t* O = gate ? SZ : XM;
#pragma unroll
        for (int ai = 0; ai < 2; ++ai)
#pragma unroll
            for (int m = 0; m < 4; ++m) { const int row = row0 + ai * 128 + m * 16; const float s = inv[row]; bf16_t* rowp = O + (size_t)row * 2048 + col0;
#pragma unroll
                for (int bj = 0; bj < 2; ++bj) { f32x4 v0 = acc[ai][bj][m][0] * s, v1 = acc[ai][bj][m][1] * s;
                    if (gate) {
#pragma unroll
                        for (int e = 0; e < 4; ++e) { v0[e] = silu_f(v0[e]); v1[e] = silu_f(v1[e]); } }
                    u32x4 w; w.x = cvt_pk_bf16(v0[0], v0[1]); w.y = cvt_pk_bf16(v0[2], v0[3]); w.z = cvt_pk_bf16(v1[0], v1[1]); w.w = cvt_pk_bf16(v1[2], v1[3]);
                    *(u32x4*)(rowp + bj * 128) = w; } }
    }
};
struct EpiRes {
    static constexpr bool PERM = true, AFTER_DRAIN = false;
    const float* base; float* out; bf16_t* xb; float* ssq;
    __device__ __forceinline__ void operator()(const f32x4 (&acc)[2][2][4][2], const pg8::Unit& u, int wr, int wc, int fr, int fq) const {
        const int row0 = u.pm * 256 + wr * 64 + fr, col0 = u.pn * 256 + wc * 32 + 8 * fq;
#pragma unroll
        for (int ai = 0; ai < 2; ++ai)
#pragma unroll
            for (int m = 0; m < 4; ++m) { const int row = row0 + ai * 128 + m * 16; const size_t off = (size_t)row * 1024 + col0; float ss = 0.f;
#pragma unroll
                for (int bj = 0; bj < 2; ++bj) { const f32x4 b0 = *(const f32x4*)(base + off + bj * 128), b1 = *(const f32x4*)(base + off + bj * 128 + 4);
                    const f32x4 o0 = b0 + acc[ai][bj][m][0], o1 = b1 + acc[ai][bj][m][1];
                    *(f32x4*)(out + off + bj * 128) = o0; *(f32x4*)(out + off + bj * 128 + 4) = o1;
                    ss += (o0[0] * o0[0] + o0[1] * o0[1]) + (o0[2] * o0[2] + o0[3] * o0[3]) + (o1[0] * o1[0] + o1[1] * o1[1]) + (o1[2] * o1[2] + o1[3] * o1[3]);
                    if (xb) { u32x4 w; w.x = cvt_pk_bf16(o0[0], o0[1]); w.y = cvt_pk_bf16(o0[2], o0[3]); w.z = cvt_pk_bf16(o1[0], o1[1]); w.w = cvt_pk_bf16(o1[2], o1[3]);
                        *(u32x4*)(xb + off + bj * 128) = w; } }
                ss += __shfl_xor(ss, 16); ss += __shfl_xor(ss, 32);
                if (fq == 0) ssq[(size_t)row * 16 + u.pn * 4 + wc] = ss;
                asm volatile("" ::: "memory"); }
    }
};
__device__ __forceinline__ float inv_from_ssq(const float* ssq, int row) {
    const f32x4* sp = (const f32x4*)(ssq + (size_t)row * 16); const f32x4 a = sp[0], b = sp[1], c = sp[2], d = sp[3];
    const float s = (((a[0] + a[1]) + (a[2] + a[3])) + ((b[0] + b[1]) + (b[2] + b[3]))) + (((c[0] + c[1]) + (c[2] + c[3])) + ((d[0] + d[1]) + (d[2] + d[3])));
    return 1.0f / sqrtf(s * (1.0f / 1024.0f) + RMS_EPS);
}
struct EpiG3 {
    static constexpr bool PERM = true, AFTER_DRAIN = false;
    const float* ssq; bf16_t* Q; bf16_t* K; bf16_t* SZ;
    __device__ __forceinline__ void operator()(const f32x4 (&acc)[2][2][4][2], const pg8::Unit& u, int wr, int wc, int fr, int fq) const {
        const int row0 = u.pm * 256 + wr * 64 + fr; const bool gate = u.pn >= 8;
        const int colw = wc * 32 + 8 * fq; bf16_t* O; int ldc, col0;
        if (u.pn < 4) { O = Q; ldc = 1024; col0 = u.pn * 256 + colw; } else if (u.pn < 8) { O = K; ldc = 1024; col0 = (u.pn - 4) * 256 + colw; } else { O = SZ; ldc = 2048; col0 = (u.pn - 8) * 256 + colw; }
#pragma unroll
        for (int ai = 0; ai < 2; ++ai)
#pragma unroll
            for (int m = 0; m < 4; ++m) { const int row = row0 + ai * 128 + m * 16; const float s = inv_from_ssq(ssq, row); bf16_t* rowp = O + (size_t)row * ldc + col0;
#pragma unroll
                for (int bj = 0; bj < 2; ++bj) { f32x4 v0 = acc[ai][bj][m][0] * s, v1 = acc[ai][bj][m][1] * s;
                    if (gate) {
#pragma unroll
                        for (int e = 0; e < 4; ++e) { v0[e] = silu_f(v0[e]); v1[e] = silu_f(v1[e]); } }
                    u32x4 w; w.x = cvt_pk_bf16(v0[0], v0[1]); w.y = cvt_pk_bf16(v0[2], v0[3]); w.z = cvt_pk_bf16(v1[0], v1[1]); w.w = cvt_pk_bf16(v1[2], v1[3]);
                    *(u32x4*)(rowp + bj * 128) = w; } }
    }
};
struct EpiVT {
    static constexpr bool PERM = true, AFTER_DRAIN = false;
    const float* ssq; bf16_t* VT;
    __device__ __forceinline__ void operator()(const f32x4 (&acc)[2][2][4][2], const pg8::Unit& u, int wr, int wc, int fr, int fq) const {
        const int row0 = u.pm * 256 + wr * 64 + fr; const int tok0 = u.pn * 256 + wc * 32 + 8 * fq;
        const float myinv = inv_from_ssq(ssq, tok0 + 128 * (fr >> 3) + (fr & 7));
        const int lane = (int)(threadIdx.x & 63);
        float sc[2][8];
#pragma unroll
        for (int bj = 0; bj < 2; ++bj)
#pragma unroll
            for (int e = 0; e < 8; ++e) sc[bj][e] = __shfl(myinv, (lane & 48) | (bj * 8 + e));
        const int b = tok0 >> 11, s0 = tok0 & 2047;
#pragma unroll
        for (int ai = 0; ai < 2; ++ai)
#pragma unroll
            for (int m = 0; m < 4; ++m) { const int row = row0 + ai * 128 + m * 16; bf16_t* rowp = VT + ((size_t)b * 2048 + row) * 2048 + s0;
#pragma unroll
                for (int bj = 0; bj < 2; ++bj) { const f32x4 v0 = acc[ai][bj][m][0], v1 = acc[ai][bj][m][1]; u32x4 w;
                    w.x = cvt_pk_bf16(v0[0] * sc[bj][0], v0[1] * sc[bj][1]); w.y = cvt_pk_bf16(v0[2] * sc[bj][2], v0[3] * sc[bj][3]);
                    w.z = cvt_pk_bf16(v1[0] * sc[bj][4], v1[1] * sc[bj][5]); w.w = cvt_pk_bf16(v1[2] * sc[bj][6], v1[3] * sc[bj][7]);
                    *(u32x4*)(rowp + bj * 128) = w; } }
    }
};

__device__ __forceinline__ void tr_item(const float* W, int ld, int K, bf16_t* WT, int kb, int nsrc0, int ndst0, const float* kscale, float mul, LAS float* scr, int lane) {
    const int k0 = 64 * kb;
#pragma unroll 8
    for (int i = 0; i < 32; ++i) { const int kk = 2 * i + (lane >> 5); float v = W[(size_t)(k0 + kk) * ld + nsrc0 + (lane & 31)]; if (kscale) v *= kscale[k0 + kk]; scr[kk * 33 + (lane & 31)] = v * mul; }
    LDS_WAIT(); asm volatile("" ::: "memory");
    const int c = lane & 7;
#pragma unroll
    for (int j = 0; j < 4; ++j) { const int n = (lane >> 3) + 8 * j; const LAS float* s = scr + (8 * c) * 33 + n;
        u32x4 o; o.x = cvt_pk_bf16(s[0 * 33], s[1 * 33]); o.y = cvt_pk_bf16(s[2 * 33], s[3 * 33]); o.z = cvt_pk_bf16(s[4 * 33], s[5 * 33]); o.w = cvt_pk_bf16(s[6 * 33], s[7 * 33]);
        *(u32x4*)(WT + (size_t)(ndst0 + n) * K + k0 + 8 * c) = o; }
    LDS_WAIT(); asm volatile("" ::: "memory");
}
struct Args { const float* x; const float* norm_g; const float* pool_w_in; const float* pool_w; const float* pool_scale; const float* pool_w_out;
              const float* sb_w_in; const float* sb_w_out; const float* norm_f; float* out; unsigned char* ws; int ph_lo, ph_hi; };

__device__ __forceinline__ void prep_phase(const Args& a, LAS unsigned char* lds, int G, int lane, int wave) {
    unsigned char* ws = a.ws;
    bf16_t* W0T = (bf16_t*)(ws + WS_W0T); bf16_t* W0OT = (bf16_t*)(ws + WS_W0OT); bf16_t* W1T = (bf16_t*)(ws + WS_W1T); bf16_t* W1OT = (bf16_t*)(ws + WS_W1OT);
    bf16_t* FA = (bf16_t*)(ws + WS_FA); bf16_t* FB = (bf16_t*)(ws + WS_FB); float* INV0 = (float*)(ws + WS_INV0); bf16_t* XB = (bf16_t*)(ws + WS_XB);
    LAS float* scr = (LAS float*)(lds + wave * 16384);
    const int gw = blockIdx.x * 8 + wave, NGW = G * 8;
    constexpr int I1 = 16 * 64, I2 = 32 * 32, I3 = 16 * 192, I4 = 32 * 32, I5 = 4 * 8 * 16, NIT = I1 + I2 + I3 + I4 + I5;
    for (int it = gw; it < NIT; it += NGW) {
        int r = it;
        if (r < I1) { const int kb = r / 64, nb = r % 64; tr_item(a.pool_w_in, 4096, 1024, W0T, kb, 2048 + 32 * nb, 2048 + 32 * nb, a.norm_g, 1.f, scr, lane); continue; } r -= I1;
        if (r < I2) { const int kb = r / 32, nb = r % 32; tr_item(a.pool_w_out, 1024, 2048, W0OT, kb, 32 * nb, 32 * nb, nullptr, 1.f, scr, lane); continue; } r -= I2;
        if (r < I3) { const int kb = r / 192, nb = r % 192; const int ns = 32 * nb; const int nd = ns < 2048 ? ns : (ns < 4096 ? ns + 2048 : ns - 2048);
                      tr_item(a.sb_w_in, 6144, 1024, W1T, kb, ns, nd, a.norm_g + 1024, ns < 1024 ? QSCALE : 1.f, scr, lane); continue; } r -= I3;
        if (r < I4) { const int kb = r / 32, nb = r % 32; tr_item(a.sb_w_out, 1024, 2048, W1OT, kb, 32 * nb, 32 * nb, nullptr, 1.f, scr, lane); continue; } r -= I4;
        { const int g = r / 128, q = r % 128, kb = q / 16, nb = q % 16; tr_item(a.pool_w + (size_t)g * 512 * 512, 512, 512, FA, kb, 32 * nb, g * 512 + 32 * nb, nullptr, 1.f, scr, lane); }
    }
    for (int k = gw; k < 1024; k += NGW) { const float gk = a.norm_g[k]; const f32x4* src = (const f32x4*)(a.pool_w_in + (size_t)k * 4096);
#pragma unroll
        for (int j = 0; j < 8; ++j) { const int c = 4 * lane + 256 * j; const f32x4 v = src[lane + 64 * j] * gk; u32x2 w; w.x = cvt_pk_bf16(v[0], v[1]); w.y = cvt_pk_bf16(v[2], v[3]);
            *(u32x2*)(FB + ((size_t)(c >> 9) * 1024 + k) * 512 + (c & 511)) = w; } }
    for (int m = gw; m < MTOK; m += NGW) { const f32x4* xr = (const f32x4*)(a.x + (size_t)m * DM) + lane; f32x4 v[4]; float s = 0.f;
#pragma unroll
        for (int j = 0; j < 4; ++j) { v[j] = xr[64 * j]; s += (v[j][0] * v[j][0] + v[j][1] * v[j][1]) + (v[j][2] * v[j][2] + v[j][3] * v[j][3]); }
        s = wave_sum(s); if (lane == 0) INV0[m] = 1.0f / sqrtf(s * (1.0f / 1024.0f) + RMS_EPS);
        u32x2* o = (u32x2*)(XB + (size_t)m * DM) + lane;
#pragma unroll
        for (int j = 0; j < 4; ++j) { u32x2 w; w.x = cvt_pk_bf16(v[j][0], v[j][1]); w.y = cvt_pk_bf16(v[j][2], v[j][3]); o[64 * j] = w; } }
}

__device__ __forceinline__ void unpack8(const u32x4 w, float (&f)[8]) { f[0] = bf_lo(w.x); f[1] = bf_hi(w.x); f[2] = bf_lo(w.y); f[3] = bf_hi(w.y); f[4] = bf_lo(w.z); f[5] = bf_hi(w.z); f[6] = bf_lo(w.w); f[7] = bf_hi(w.w); }
__device__ __forceinline__ void pool_phase(const bf16_t* XM, bf16_t* SZY, const float* scale, int G, int tid) {
    for (int task = blockIdx.x * 512 + tid; task < BATCH * 32 * 256; task += G * 512) {
        const int cc = task & 255, rc = (task >> 8) & 31, b = task >> 13, c0 = cc * 8, w = 2 << (c0 >> 9), ts = rc * 64;
        const size_t base = (size_t)b * SEQ * 2048 + c0;
        float sc[8]; { const f32x4 s0 = *(const f32x4*)(scale + c0), s1 = *(const f32x4*)(scale + c0 + 4); sc[0] = s0[0]; sc[1] = s0[1]; sc[2] = s0[2]; sc[3] = s0[3]; sc[4] = s1[0]; sc[5] = s1[1]; sc[6] = s1[2]; sc[7] = s1[3]; }
        float sum[8];
#pragma unroll
        for (int e = 0; e < 8; ++e) sum[e] = 0.f;
        for (int j = (ts - w + 1 > 0 ? ts - w + 1 : 0); j < ts; ++j) { float f[8]; unpack8(*(const u32x4*)(XM + base + (size_t)j * 2048), f);
#pragma unroll
            for (int e = 0; e < 8; ++e) sum[e] += f[e]; }
#pragma unroll 4
        for (int t = ts; t < ts + 64; ++t) {
            float cur[8], z[8], old[8]; unpack8(*(const u32x4*)(XM + base + (size_t)t * 2048), cur); unpack8(*(const u32x4*)(SZY + base + (size_t)t * 2048), z);
            const int jo = t - w + 1; const bool has_old = jo >= 0;
            unpack8(*(const u32x4*)(XM + base + (size_t)(has_old ? jo : 0) * 2048), old);
            const float rc_ = 1.0f / (float)(t + 1 < w ? t + 1 : w);
            float y[8];
#pragma unroll
            for (int e = 0; e < 8; ++e) { sum[e] += cur[e]; y[e] = (sum[e] * rc_ - cur[e]) * sc[e] * z[e]; sum[e] -= has_old ? old[e] : 0.f; }
            u32x4 o; o.x = cvt_pk_bf16(y[0], y[1]); o.y = cvt_pk_bf16(y[2], y[3]); o.z = cvt_pk_bf16(y[4], y[5]); o.w = cvt_pk_bf16(y[6], y[7]);
            *(u32x4*)(SZY + base + (size_t)t * 2048) = o;
        }
    }
}

__device__ __forceinline__ bf16x8 pack8(const float* a) { u32x4 w; w.x = cvt_pk_bf16(a[0], a[1]); w.y = cvt_pk_bf16(a[2], a[3]); w.z = cvt_pk_bf16(a[4], a[5]); w.w = cvt_pk_bf16(a[6], a[7]); return __builtin_bit_cast(bf16x8, w); }
__device__ __forceinline__ void attn_phase(const bf16_t* __restrict__ Q, const bf16_t* __restrict__ Kp, const bf16_t* __restrict__ VT, bf16_t* Y, int G, int lane, int wave) {
    const int n = lane & 31, hi = lane >> 5;
    const int pmr = (n & 19) | ((n & 4) << 1) | ((n & 8) >> 1);
    for (int u = blockIdx.x * 8 + wave; u < BATCH * NH * 64; u += G * 8) {
        const int bh = u >> 6, qb = u & 63, b = bh >> 4, h = bh & 15, t0 = qb * 32, t = t0 + n;
        const bf16_t* qrow = Q + (size_t)(b * SEQ + t) * 1024 + h * 64 + hi * 8;
        bf16x8 qf[4];
#pragma unroll
        for (int c = 0; c < 4; ++c) qf[c] = *(const bf16x8*)(qrow + 16 * c);
        const bf16_t* kbase = Kp + (size_t)(b * SEQ + pmr) * 1024 + h * 64 + hi * 8;
        const bf16_t* vbase = VT + ((size_t)b * 2048 + h * 128 + n) * 2048 + hi * 8;
        f32x16 o[4];
#pragma unroll
        for (int blk = 0; blk < 4; ++blk)
#pragma unroll
            for (int e = 0; e < 16; ++e) o[blk][e] = 0.f;
        float carry = 1.f;
        for (int kb = qb; kb >= 0; --kb) {
            const int key0 = kb * 32;
            const bf16_t* kr = kbase + (size_t)key0 * 1024;
            bf16x8 kf[4], vf[4][2];
#pragma unroll
            for (int c = 0; c < 4; ++c) kf[c] = *(const bf16x8*)(kr + 16 * c);
#pragma unroll
            for (int blk = 0; blk < 4; ++blk)
#pragma unroll
                for (int c = 0; c < 2; ++c) vf[blk][c] = *(const bf16x8*)(vbase + (size_t)blk * 32 * 2048 + key0 + 16 * c);
            f32x16 s;
#pragma unroll
            for (int e = 0; e < 16; ++e) s[e] = 0.f;
#pragma unroll
            for (int c = 0; c < 4; ++c) s = __builtin_amdgcn_mfma_f32_32x32x16_bf16(kf[c], qf[c], s, 0, 0, 0);
            float om[16], be[16], ex[16];
#pragma unroll
            for (int e = 0; e < 16; ++e) { const float ez = __builtin_amdgcn_exp2f(fminf(s[e], 120.f)); const float r = __builtin_amdgcn_rcpf(1.0f + ez); om[e] = r; be[e] = ez * r; }
            if (kb == qb) {
#pragma unroll
                for (int e = 0; e < 16; ++e) { const int key = key0 + 16 * (e >> 3) + 8 * hi + (e & 7); const bool v = key < t; om[e] = v ? om[e] : 1.f; be[e] = v ? be[e] : 0.f; } }
            float run = 1.f;
#pragma unroll
            for (int e = 7; e >= 0; --e) { ex[e] = run; run *= om[e]; }
            const float pA = run; run = 1.f;
#pragma unroll
            for (int e = 15; e >= 8; --e) { ex[e] = run; run *= om[e]; }
            const float pB = run;
            const float pAo = __shfl_xor(pA, 32), pBo = __shfl_xor(pB, 32);
            const float mB = (hi ? 1.f : pBo) * carry;
            const float mA = (hi ? pB * pBo : pAo * pB * pBo) * carry;
            float av[16];
#pragma unroll
            for (int e = 0; e < 16; ++e) av[e] = be[e] * ex[e] * (e < 8 ? mA : mB);
            carry *= (pA * pAo) * (pB * pBo);
            const bf16x8 pf0 = pack8(av), pf1 = pack8(av + 8);
#pragma unroll
            for (int blk = 0; blk < 4; ++blk) { o[blk] = __builtin_amdgcn_mfma_f32_32x32x16_bf16(vf[blk][0], pf0, o[blk], 0, 0, 0); o[blk] = __builtin_amdgcn_mfma_f32_32x32x16_bf16(vf[blk][1], pf1, o[blk], 0, 0, 0); }
            if (__all(carry < 1e-30f)) break;
        }
        bf16_t* yrow = Y + (size_t)(b * SEQ + t) * 2048 + h * 128 + 4 * hi;
#pragma unroll
        for (int blk = 0; blk < 4; ++blk)
#pragma unroll
            for (int i = 0; i < 4; ++i) { u32x2* p = (u32x2*)(yrow + 32 * blk + 8 * i); const u32x2 z = *p; u32x2 w;
                w.x = cvt_pk_bf16(o[blk][4 * i + 0] * bf_lo(z.x), o[blk][4 * i + 1] * bf_hi(z.x)); w.y = cvt_pk_bf16(o[blk][4 * i + 2] * bf_lo(z.y), o[blk][4 * i + 3] * bf_hi(z.y)); *p = w; }
    }
}

__global__ void __launch_bounds__(512, 2) mk_fwd(Args a) {
    extern __shared__ __attribute__((aligned(16))) unsigned char lds_raw[];
    cg::grid_group grid = cg::this_grid();
    LAS unsigned char* lds = (LAS unsigned char*)lds_raw;
    const int tid = threadIdx.x, lane = tid & 63, wave = __builtin_amdgcn_readfirstlane(tid >> 6), G = gridDim.x;
    unsigned char* ws = a.ws;
    bf16_t* W0T = (bf16_t*)(ws + WS_W0T); bf16_t* W0OT = (bf16_t*)(ws + WS_W0OT); bf16_t* W1T = (bf16_t*)(ws + WS_W1T); bf16_t* W1OT = (bf16_t*)(ws + WS_W1OT);
    bf16_t* FA = (bf16_t*)(ws + WS_FA); bf16_t* FB = (bf16_t*)(ws + WS_FB); float* INV0 = (float*)(ws + WS_INV0); float* SSQ1 = (float*)(ws + WS_SSQ1); float* SSQ2 = (float*)(ws + WS_SSQ2);
    bf16_t* XB = (bf16_t*)(ws + WS_XB); bf16_t* RA = (bf16_t*)(ws + WS_A); bf16_t* RB = (bf16_t*)(ws + WS_B); bf16_t* RC = (bf16_t*)(ws + WS_C);
    const int lo = a.ph_lo, hi = a.ph_hi;
#define IN(k) (lo <= (k) && (k) < hi)
#define SEAM(k) do { if (IN(k) && IN((k) + 1)) grid.sync(); } while (0)
    constexpr int NOGRP = 30;
    if (IN(0)) { prep_phase(a, lds, G, lane, wave); __syncthreads(); }
    SEAM(0);
    if (IN(1)) { pg8::Gemm g{FA, FB, 2048, 1024, 512, 1, (size_t)1024 * 512 * 2}; pg8::StaticOrder S; S.init(2048, 1024, G, (int)blockIdx.x);
        EpiStore E{W0T, 1024}; pg8::gemm_phase<EpiStore, pg8::StaticOrder, true, true>(lds, g, S, E); }
    SEAM(1);
    if (IN(2)) { pg8::Gemm g{XB, W0T, MTOK, 4096, 1024, NOGRP, 0}; pg8::StaticOrder S; S.init(MTOK, 4096, G, (int)blockIdx.x);
        EpiG1 E{INV0, RA, RB}; pg8::gemm_phase<EpiG1, pg8::StaticOrder, true, true>(lds, g, S, E); }
    SEAM(2);
    if (IN(3)) pool_phase(RA, RB, a.pool_scale, G, tid);
    SEAM(3);
    if (IN(4)) { pg8::Gemm g{RB, W0OT, MTOK, 1024, 2048, NOGRP, 0}; pg8::StaticOrder S; S.init(MTOK, 1024, G, (int)blockIdx.x);
        EpiRes E{a.x, a.out, XB, SSQ1}; pg8::gemm_phase<EpiRes, pg8::StaticOrder, true, true>(lds, g, S, E); }
    SEAM(4);
    if (IN(5)) {
        { pg8::Gemm g{XB, W1T, MTOK, 4096, 1024, NOGRP, 0}; pg8::StaticOrder S; S.init(MTOK, 4096, G, (int)blockIdx.x);
          EpiG3 E{SSQ1, RA, RA + (size_t)MTOK * 1024, RC}; pg8::gemm_phase<EpiG3, pg8::StaticOrder, true, true>(lds, g, S, E); }
        { pg8::Gemm g{W1T + (size_t)4096 * 1024, XB, 2048, MTOK, 1024, NOGRP, 0}; pg8::StaticOrder S; S.init(2048, MTOK, G, (int)blockIdx.x);
          EpiVT E{SSQ1, RB}; pg8::gemm_phase<EpiVT, pg8::StaticOrder, true, true>(lds, g, S, E); }
    }
    SEAM(5);
    if (IN(6)) attn_phase(RA, RA + (size_t)MTOK * 1024, RB, RC, G, lane, wave);
    SEAM(6);
    if (IN(7)) { pg8::Gemm g{RC, W1OT, MTOK, 1024, 2048, NOGRP, 0}; pg8::StaticOrder S; S.init(MTOK, 1024, G, (int)blockIdx.x);
        EpiRes E{a.out, a.out, nullptr, SSQ2}; pg8::gemm_phase<EpiRes, pg8::StaticOrder, true, true>(lds, g, S, E); }
    SEAM(7);
    if (IN(8)) { const int gw = blockIdx.x * 8 + wave, NGW = G * 8;
        f32x4 gf[4];
#pragma unroll
        for (int j = 0; j < 4; ++j) gf[j] = ((const f32x4*)a.norm_f)[lane + 64 * j];
        for (int m = gw; m < MTOK; m += NGW) { const float inv = inv_from_ssq(SSQ2, m); f32x4* r = (f32x4*)(a.out + (size_t)m * DM) + lane;
#pragma unroll
            for (int j = 0; j < 4; ++j) r[64 * j] = r[64 * j] * inv * gf[j]; } }
#undef IN
#undef SEAM
}

extern "C" void kernel_launch(void* const* d_in, const int* in_sizes, int n_in, void* d_out, int out_size, void* d_ws, size_t ws_size, hipStream_t stream) {
    static int grid = 0;
    if (grid == 0) {
        if (n_in != 9 || in_sizes[0] != MTOK * DM || out_size != MTOK * DM || ws_size < WS_END) { fprintf(stderr, "kernel_launch: unexpected shapes (n_in %d, in0 %d, out %d, ws %zu)\n", n_in, n_in > 0 ? in_sizes[0] : -1, out_size, ws_size); grid = -1; return; }
        int dev = 0, cus = 0, per_cu = 0;
        (void)hipGetDevice(&dev); (void)hipDeviceGetAttribute(&cus, hipDeviceAttributeMultiprocessorCount, dev);
        if (hipFuncSetAttribute((const void*)mk_fwd, hipFuncAttributeMaxDynamicSharedMemorySize, LDS_BYTES) != hipSuccess) { fprintf(stderr, "kernel_launch: hipFuncSetAttribute failed\n"); grid = -1; return; }
        if (hipOccupancyMaxActiveBlocksPerMultiprocessor(&per_cu, (const void*)mk_fwd, 512, LDS_BYTES) != hipSuccess || per_cu < 1) { fprintf(stderr, "kernel_launch: occupancy query failed (%d)\n", per_cu); (void)hipGetLastError(); per_cu = 1; }
        if (per_cu > 1) per_cu = 1;
        grid = cus * per_cu;
        if (grid <= 0) { grid = -1; return; }
    }
    if (grid < 0) return;
    Args a{};
    a.x = (const float*)d_in[0]; a.norm_g = (const float*)d_in[1]; a.pool_w_in = (const float*)d_in[2]; a.pool_w = (const float*)d_in[3]; a.pool_scale = (const float*)d_in[4];
    a.pool_w_out = (const float*)d_in[5]; a.sb_w_in = (const float*)d_in[6]; a.sb_w_out = (const float*)d_in[7]; a.norm_f = (const float*)d_in[8];
    a.out = (float*)d_out; a.ws = (unsigned char*)d_ws;
#if MK_SPLIT
    for (int p = 0; p < NPHASE; ++p) { a.ph_lo = p; a.ph_hi = p + 1; void* args[] = {&a};
        hipError_t e = hipLaunchCooperativeKernel((const void*)mk_fwd, dim3(grid), dim3(512), args, LDS_BYTES, stream);
        if (e != hipSuccess) { fprintf(stderr, "kernel_launch: cooperative launch (phase %d) failed: %s (grid %d)\n", p, hipGetErrorString(e), grid); break; } }
#else
    a.ph_lo = 0; a.ph_hi = NPHASE; void* args[] = {&a};
    hipError_t e = hipLaunchCooperativeKernel((const void*)mk_fwd, dim3(grid), dim3(512), args, LDS_BYTES, stream);
    if (e != hipSuccess) fprintf(stderr, "kernel_launch: cooperative launch failed: %s (grid %d)\n", hipGetErrorString(e), grid);
#endif
}
```

```cpp
#include <hip/hip_runtime.h>
#include <hip/hip_cooperative_groups.h>
#include <cstdio>
#include <cstdint>
namespace cg = cooperative_groups;
namespace pg8 {
#define PG8_LAS __attribute__((address_space(3)))
typedef unsigned short bf16_t;
typedef short bf16x8 __attribute__((ext_vector_type(8)));
typedef float f32x4 __attribute__((ext_vector_type(4)));
typedef unsigned u32x4 __attribute__((ext_vector_type(4)));
constexpr int BM = 256, BK = 64, HALF = 128, HTB = HALF * BK * 2  , STAGE_BYTES = 8 * HTB, NXCD = 8, WGM = 8;

__host__ __device__ __forceinline__ int lds_byte(int r, int c) { const int st = (r >> 4) * 2 + (c >> 5), rr = r & 15, cc = c & 31, ob = rr * 64 + cc * 2; return st * 1024 + (ob ^ (((ob >> 9) & 1) << 5)); }
__host__ __device__ __forceinline__ void stage_rc(int b, int& R, int& C) { const int st = b / 1024, sb = b % 1024, swz = sb ^ (((sb >> 9) & 1) << 5); R = (st >> 1) * 16 + swz / 64; C = (st & 1) * 32 + (swz % 64) / 2; }
__host__ __device__ __forceinline__ int perm32(int rho) { const int n = rho >> 4, i = rho & 15; return 8 * (i >> 2) + 4 * n + (i & 3); }

struct Unit { int pm, pn; };
struct Gemm { const bf16_t* A; const bf16_t* Bt; int M, N, K; int gshift; size_t gstride; };

struct StaticOrder {
    int nM, nN, nwg, G, c;
    __host__ __device__ void init(int M, int N, int G_, int c_) { nM = M / BM; nN = N / BM; nwg = nM * nN; G = G_; c = c_; }
    __host__ __device__ bool next(int i, Unit& u) const {
        const long L = (long)i * G + c; if (L >= nwg) return false;
        int wgid = (int)L; { const int q = nwg / NXCD, r = nwg % NXCD, xcd = wgid % NXCD, off = wgid / NXCD; wgid = (xcd < r ? xcd * (q + 1) : r * (q + 1) + (xcd - r) * q) + off; }
        const int nig = WGM * nN, gid = wgid / nig, fm = gid * WGM, gsz = (nM - fm) < WGM ? (nM - fm) : WGM;
        u.pm = fm + ((wgid % nig) % gsz); u.pn = (wgid % nig) / gsz; return true;
    }
    __device__ __forceinline__ void a_ready(const Unit&) const {}
    __device__ __forceinline__ void done(const Unit&) const {}
};

__device__ __forceinline__ unsigned cvt_pk_bf16(float lo, float hi) { unsigned r; asm volatile("v_cvt_pk_bf16_f32 %0, %1, %2" : "=v"(r) : "v"(lo), "v"(hi)); return r; }

template <class Epi, class Sched, bool ALIGN_EPI = false, bool SP2 = false>
__device__ __forceinline__ void gemm_phase(PG8_LAS unsigned char* lds, const Gemm g, const Sched& S, const Epi& E) {
    const int tid = threadIdx.x, wid = __builtin_amdgcn_readfirstlane(tid >> 6), lane = tid & 63, wr = wid >> 2, wc = wid & 3, fr = lane & 15, fq = lane >> 4;
    const int K = g.K, nt = K / BK;
    unsigned voffA[2], voffB[2];
#pragma unroll
    for (int i = 0; i < 2; ++i) { int R, C; stage_rc(tid * 16 + i * 8192, R, C); const int Rb = Epi::PERM ? ((R & ~31) + perm32(R & 31)) : R;
        voffA[i] = (unsigned)(R * K + C) * 2u; voffB[i] = (unsigned)(Rb * K + C) * 2u; }
    const size_t kstep = (size_t)(BK * 2);
    const size_t hstep = (size_t)HALF * K * 2;
    const size_t tstep = 2 * hstep;
    const unsigned ldsw = (unsigned)wid * 1024u;
    const int aoff = lds_byte(wr * 64 + fr, fq * 8), boff = lds_byte(wc * 32 + fr, fq * 8);
#define PG8_SA(b, h) (((b) * 2 + (h)) * HTB)
#define PG8_SB(b, h) ((4 + (b) * 2 + (h)) * HTB)
#define PG8_STAGE(bufoff, gbase, voff) do { _Pragma("unroll") for (int _i = 0; _i < 2; ++_i) \
        __builtin_amdgcn_global_load_lds((const unsigned*)((const char*)(gbase) + (voff)[_i]), (PG8_LAS unsigned*)(lds + (bufoff) + ldsw + _i * 8192), 16, 0, 0); } while (0)
#define PG8_LDA(dst, b, h) do { _Pragma("unroll") for (int m = 0; m < 4; ++m) _Pragma("unroll") for (int k = 0; k < 2; ++k) dst[m][k] = *(const PG8_LAS bf16x8*)(lds + PG8_SA(b, h) + aoff + m * 2048 + k * 1024); } while (0)
#define PG8_LDB(dst, b, h) do { _Pragma("unroll") for (int n = 0; n < 2; ++n) _Pragma("unroll") for (int k = 0; k < 2; ++k) dst[n][k] = *(const PG8_LAS bf16x8*)(lds + PG8_SB(b, h) + boff + n * 2048 + k * 1024); } while (0)
#define PG8_MMA(ai, bj, At, Bt) do { __builtin_amdgcn_s_setprio(1); _Pragma("unroll") for (int m = 0; m < 4; ++m) _Pragma("unroll") for (int n = 0; n < 2; ++n) _Pragma("unroll") for (int k = 0; k < 2; ++k) \
        acc[ai][bj][m][n] = __builtin_amdgcn_mfma_f32_16x16x32_bf16(Bt[n][k], At[m][k], acc[ai][bj][m][n], 0, 0, 0); __builtin_amdgcn_s_setprio(0); } while (0)
#define PG8_WAIT_V(n) asm volatile("s_waitcnt vmcnt(" #n ")" ::: "memory")
#define PG8_WAIT_L(n) asm volatile("s_waitcnt lgkmcnt(" #n ")" ::: "memory")
#define PG8_BAR __builtin_amdgcn_s_barrier()
#define PG8_SCHED __builtin_amdgcn_sched_barrier(0)
    Unit cur, nxt; int ui = 0;
    if (!S.next(0, cur)) return;
    f32x4 acc[2][2][4][2];
#pragma unroll
    for (int a = 0; a < 2; ++a)
#pragma unroll
        for (int b = 0; b < 2; ++b)
#pragma unroll
            for (int m = 0; m < 4; ++m)
#pragma unroll
                for (int n = 0; n < 2; ++n) acc[a][b][m][n] = (f32x4){0.f, 0.f, 0.f, 0.f};
    bf16x8 At[4][2], B0[2][2], B1[2][2];
    const char* cA = (const char*)g.A + (size_t)cur.pm * tstep; const char* cB = (const char*)g.Bt + (size_t)(cur.pm >> g.gshift) * g.gstride + (size_t)cur.pn * tstep;
    S.a_ready(cur);
    if constexpr (SP2) {
        PG8_STAGE(PG8_SB(0, 0), cB, voffB); PG8_STAGE(PG8_SB(0, 1), cB + hstep, voffB); PG8_STAGE(PG8_SA(0, 0), cA, voffA); PG8_STAGE(PG8_SA(0, 1), cA + hstep, voffA);
        if (wr == 1) PG8_BAR;
        PG8_WAIT_V(2); PG8_BAR;
        PG8_STAGE(PG8_SB(1, 0), cB + kstep, voffB); PG8_STAGE(PG8_SA(1, 0), cA + kstep, voffA); PG8_STAGE(PG8_SB(1, 1), cB + hstep + kstep, voffB);
        PG8_WAIT_V(6); PG8_BAR;
    } else {
        PG8_STAGE(PG8_SB(0, 0), cB, voffB); PG8_STAGE(PG8_SA(0, 0), cA, voffA); PG8_STAGE(PG8_SB(0, 1), cB + hstep, voffB); PG8_STAGE(PG8_SA(0, 1), cA + hstep, voffA);
        if (wr == 1) PG8_BAR;
        PG8_WAIT_V(4); PG8_BAR;
        PG8_STAGE(PG8_SB(1, 0), cB + kstep, voffB); PG8_STAGE(PG8_SA(1, 0), cA + kstep, voffA); PG8_STAGE(PG8_SB(1, 1), cB + hstep + kstep, voffB);
        PG8_WAIT_V(6); PG8_BAR;
    }
    for (;;) {
        const bool has_next = S.next(ui + 1, nxt);
        const char* nA = has_next ? (const char*)g.A + (size_t)nxt.pm * tstep : cA; const char* nB = has_next ? (const char*)g.Bt + (size_t)(nxt.pm >> g.gshift) * g.gstride + (size_t)nxt.pn * tstep : cB;
        for (int t = 0; t < nt; t += 2) {
            const bool last = (t == nt - 2);
            const char* a1 = cA + (size_t)(t + 1) * kstep;
            const char* a2 = last ? nA : cA + (size_t)(t + 2) * kstep; const char* b2 = last ? nB : cB + (size_t)(t + 2) * kstep;
            const char* a3 = a2 + kstep; const char* b3 = b2 + kstep;
            if (last && has_next) S.a_ready(nxt);
            if constexpr (SP2) {
            PG8_LDB(B0, 0, 0); PG8_LDB(B1, 0, 1); PG8_SCHED; PG8_LDA(At, 0, 0); PG8_STAGE(PG8_SA(1, 1), a1 + hstep, voffA);
            PG8_WAIT_V(8); PG8_WAIT_L(0); PG8_BAR; PG8_MMA(0, 0, At, B0); PG8_MMA(0, 1, At, B1); PG8_BAR; PG8_SCHED;
            PG8_LDA(At, 0, 1); PG8_STAGE(PG8_SB(0, 0), b2, voffB); PG8_STAGE(PG8_SB(0, 1), b2 + hstep, voffB); PG8_STAGE(PG8_SA(0, 0), a2, voffA);
            PG8_WAIT_V(8); PG8_WAIT_L(0); PG8_BAR; PG8_MMA(1, 0, At, B0); PG8_MMA(1, 1, At, B1); PG8_BAR; PG8_SCHED;
            PG8_LDB(B0, 1, 0); PG8_LDB(B1, 1, 1); PG8_SCHED; PG8_LDA(At, 1, 0); PG8_STAGE(PG8_SA(0, 1), a2 + hstep, voffA);
            PG8_WAIT_V(8); PG8_WAIT_L(0); PG8_BAR; PG8_MMA(0, 0, At, B0); PG8_MMA(0, 1, At, B1); PG8_BAR; PG8_SCHED;
            PG8_LDA(At, 1, 1); PG8_STAGE(PG8_SB(1, 0), b3, voffB); PG8_STAGE(PG8_SB(1, 1), b3 + hstep, voffB); PG8_STAGE(PG8_SA(1, 0), a3, voffA);
            PG8_WAIT_V(8); PG8_WAIT_L(0); PG8_BAR; PG8_MMA(1, 0, At, B0); PG8_MMA(1, 1, At, B1); PG8_BAR; PG8_SCHED;
            } else {
            PG8_LDB(B0, 0, 0); PG8_SCHED; PG8_LDA(At, 0, 0); PG8_STAGE(PG8_SA(1, 1), a1 + hstep, voffA);
            PG8_WAIT_L(8); PG8_BAR; PG8_WAIT_L(0); PG8_MMA(0, 0, At, B0); PG8_BAR; PG8_SCHED;
            PG8_LDB(B1, 0, 1); PG8_STAGE(PG8_SB(0, 0), b2, voffB);
            PG8_BAR; PG8_WAIT_L(0); PG8_MMA(0, 1, At, B1); PG8_BAR;
            PG8_LDA(At, 0, 1); PG8_STAGE(PG8_SA(0, 0), a2, voffA);
            PG8_BAR; PG8_WAIT_L(0); PG8_MMA(1, 0, At, B0); PG8_BAR; PG8_SCHED;
            PG8_STAGE(PG8_SB(0, 1), b2 + hstep, voffB);
            PG8_WAIT_V(6); PG8_BAR; PG8_MMA(1, 1, At, B1); PG8_BAR;
            PG8_LDB(B0, 1, 0); PG8_SCHED; PG8_LDA(At, 1, 0); PG8_STAGE(PG8_SA(0, 1), a2 + hstep, voffA);
            PG8_WAIT_L(8); PG8_BAR; PG8_WAIT_L(0); PG8_MMA(0, 0, At, B0); PG8_BAR; PG8_SCHED;
            PG8_LDB(B1, 1, 1); PG8_STAGE(PG8_SB(1, 0), b3, voffB);
            PG8_BAR; PG8_WAIT_L(0); PG8_MMA(0, 1, At, B1); PG8_BAR;
            PG8_LDA(At, 1, 1); PG8_STAGE(PG8_SA(1, 0), a3, voffA);
            PG8_BAR; PG8_WAIT_L(0); PG8_MMA(1, 0, At, B0); PG8_BAR; PG8_SCHED;
            PG8_STAGE(PG8_SB(1, 1), b3 + hstep, voffB);
            PG8_WAIT_V(6); PG8_BAR; PG8_MMA(1, 1, At, B1); PG8_BAR;
            }
        }
        if constexpr (ALIGN_EPI) { if (wr == 0) PG8_BAR; }
        if constexpr (!Epi::AFTER_DRAIN) { E(acc, cur, wr, wc, fr, fq); S.done(cur); }
        if (!has_next) break;
#pragma unroll
        for (int a = 0; a < 2; ++a)
#pragma unroll
            for (int b = 0; b < 2; ++b)
#pragma unroll
                for (int m = 0; m < 4; ++m)
#pragma unroll
                    for (int n = 0; n < 2; ++n) acc[a][b][m][n] = (f32x4){0.f, 0.f, 0.f, 0.f};
        cur = nxt; cA = nA; cB = nB; ++ui;
        if constexpr (ALIGN_EPI) { if (wr == 1) PG8_BAR; }
    }
    PG8_WAIT_V(0);
    if constexpr (!ALIGN_EPI) { if (wr == 0) PG8_BAR; }
    PG8_BAR;
    if constexpr (Epi::AFTER_DRAIN) { E.fused(acc, cur, wr, wc, fr, fq, lds, wid, lane); S.done(cur); }
#undef PG8_SA
#undef PG8_SB
#undef PG8_STAGE
#undef PG8_LDA
#undef PG8_LDB
#undef PG8_MMA
#undef PG8_WAIT_V
#undef PG8_WAIT_L
#undef PG8_BAR
#undef PG8_SCHED
}
}

#ifndef MK_PROBE
#define MK_PROBE 0
#endif
#ifndef MK_SPLIT
#define MK_SPLIT 0
#endif
constexpr int DM = 1024, BATCH = 16, SEQ = 2048, MTOK = BATCH * SEQ, DI = 2048, NH = 16, DK = 64, DV = 128;
constexpr float RMS_EPS = 1e-6f;
constexpr float QSCALE = 0.125f * 1.4426950408889634f;
constexpr int NPHASE = 9;
constexpr size_t MiB = 1u << 20;
constexpr size_t WS_W0T = 0;
constexpr size_t WS_W0OT = 8 * MiB;
constexpr size_t WS_W1T = 12 * MiB;
constexpr size_t WS_W1OT = 24 * MiB;
constexpr size_t WS_FA = 28 * MiB;
constexpr size_t WS_FB = 30 * MiB;
constexpr size_t WS_INV0 = 34 * MiB;
constexpr size_t WS_SSQ1 = 35 * MiB;
constexpr size_t WS_SSQ2 = 37 * MiB;
constexpr size_t WS_CTL = 39 * MiB, CTL_BYTES = 16384;
constexpr size_t WS_XB = 40 * MiB;
constexpr size_t WS_A = 104 * MiB;
constexpr size_t WS_B = 232 * MiB;
constexpr size_t WS_C = 360 * MiB;
constexpr size_t WS_END = 488 * MiB;
constexpr int MISC_OFF = 131072;
constexpr int LDS_BYTES = 147456;

#define LAS __attribute__((address_space(3)))
typedef unsigned short bf16_t;
typedef short bf16x8 __attribute__((ext_vector_type(8)));
typedef float f32x4 __attribute__((ext_vector_type(4)));
typedef float f32x16 __attribute__((ext_vector_type(16)));
typedef unsigned u32x4 __attribute__((ext_vector_type(4)));
typedef unsigned u32x2 __attribute__((ext_vector_type(2)));
using pg8::cvt_pk_bf16;
#define LDS_WAIT() asm volatile("s_waitcnt lgkmcnt(0)" ::: "memory")

__device__ __forceinline__ float bf_lo(unsigned w) { return __uint_as_float(w << 16); }
__device__ __forceinline__ float bf_hi(unsigned w) { return __uint_as_float(w & 0xffff0000u); }
__device__ __forceinline__ float silu_f(float v) { return v * __builtin_amdgcn_rcpf(1.0f + __builtin_amdgcn_exp2f(-1.4426950408889634f * v)); }
__device__ __forceinline__ float wave_sum(float v) {
#pragma unroll
    for (int o = 1; o < 64; o <<= 1) v += __shfl_xor(v, o);
    return v;
}

struct EpiStore {
    static constexpr bool PERM = true, AFTER_DRAIN = false;
    bf16_t* O; int ldc;
    __device__ __forceinline__ void operator()(const f32x4 (&acc)[2][2][4][2], const pg8::Unit& u, int wr, int wc, int fr, int fq) const {
        const int row0 = u.pm * 256 + wr * 64 + fr, col0 = u.pn * 256 + wc * 32 + 8 * fq;
#pragma unroll
        for (int ai = 0; ai < 2; ++ai)
#pragma unroll
            for (int m = 0; m < 4; ++m) { bf16_t* rowp = O + (size_t)(row0 + ai * 128 + m * 16) * ldc + col0;
#pragma unroll
                for (int bj = 0; bj < 2; ++bj) { const f32x4 v0 = acc[ai][bj][m][0], v1 = acc[ai][bj][m][1]; u32x4 w;
                    w.x = cvt_pk_bf16(v0[0], v0[1]); w.y = cvt_pk_bf16(v0[2], v0[3]); w.z = cvt_pk_bf16(v1[0], v1[1]); w.w = cvt_pk_bf16(v1[2], v1[3]);
                    *(u32x4*)(rowp + bj * 128) = w; } }
    }
};
struct EpiG1 {
    static constexpr bool PERM = true, AFTER_DRAIN = false;
    const float* inv; bf16_t* XM; bf16_t* SZ;
    __device__ __forceinline__ void operator()(const f32x4 (&acc)[2][2][4][2], const pg8::Unit& u, int wr, int wc, int fr, int fq) const {
        const int row0 = u.pm * 256 + wr * 64 + fr; const bool gate = u.pn >= 8;
        const int col0 = (u.pn & 7) * 256 + wc * 32 + 8 * fq; bf16_t* O = gate ? SZ : XM;
#pragma unroll
        for (int ai = 0; ai < 2; ++ai)
#pragma unroll
            for (int m = 0; m < 4; ++m) { const int row = row0 + ai * 128 + m * 16; const float s = inv[row]; bf16_t* rowp = O + (size_t)row * 2048 + col0;
#pragma unroll
                for (int bj = 0; bj < 2; ++bj) { f32x4 v0 = acc[ai][bj][m][0] * s, v1 = acc[ai][bj][m][1] * s;
                    if (gate) {
#pragma unroll
                        for (int e = 0; e < 4; ++e) { v0[e] = silu_f(v0[e]); v1[e] = silu_f(v1[e]); } }
                    u32x4 w; w.x = cvt_pk_bf16(v0[0], v0[1]); w.y = cvt_pk_bf16(v0[2], v0[3]); w.z = cvt_pk_bf16(v1[0], v1[1]); w.w = cvt_pk_bf16(v1[2], v1[3]);
                    *(u32x4*)(rowp + bj * 128) = w; } }
    }
};
struct EpiRes {
    static constexpr bool PERM = true, AFTER_DRAIN = false;
    const float* base; float* out; bf16_t* xb; float* ssq;
    __device__ __forceinline__ void operator()(const f32x4 (&acc)[2][2][4][2], const pg8::Unit& u, int wr, int wc, int fr, int fq) const {
        const int row0 = u.pm * 256 + wr * 64 + fr, col0 = u.pn * 256 + wc * 32 + 8 * fq;
#pragma unroll
        for (int ai = 0; ai < 2; ++ai)
#pragma unroll
            for (int m = 0; m < 4; ++m) { const int row = row0 + ai * 128 + m * 16; const size_t off = (size_t)row * 1024 + col0; float ss = 0.f;
#pragma unroll
                for (int bj = 0; bj < 2; ++bj) { const f32x4 b0 = *(const f32x4*)(base + off + bj * 128), b1 = *(const f32x4*)(base + off + bj * 128 + 4);
                    const f32x4 o0 = b0 + acc[ai][bj][m][0], o1 = b1 + acc[ai][bj][m][1];
                    *(f32x4*)(out + off + bj * 128) = o0; *(f32x4*)(out + off + bj * 128 + 4) = o1;
                    ss += (o0[0] * o0[0] + o0[1] * o0[1]) + (o0[2] * o0[2] + o0[3] * o0[3]) + (o1[0] * o1[0] + o1[1] * o1[1]) + (o1[2] * o1[2] + o1[3] * o1[3]);
                    if (xb) { u32x4 w; w.x = cvt_pk_bf16(o0[0], o0[1]); w.y = cvt_pk_bf16(o0[2], o0[3]); w.z = cvt_pk_bf16(o1[0], o1[1]); w.w = cvt_pk_bf16(o1[2], o1[3]);
                        *(u32x4*)(xb + off + bj * 128) = w; } }
                ss += __shfl_xor(ss, 16); ss += __shfl_xor(ss, 32);
                if (fq == 0) ssq[(size_t)row * 16 + u.pn * 4 + wc] = ss;
                asm volatile("" ::: "memory"); }
    }
};
__device__ __forceinline__ float inv_from_ssq(const float* ssq, int row) {
    const f32x4* sp = (const f32x4*)(ssq + (size_t)row * 16); const f32x4 a = sp[0], b = sp[1], c = sp[2], d = sp[3];
    const float s = (((a[0] + a[1]) + (a[2] + a[3])) + ((b[0] + b[1]) + (b[2] + b[3]))) + (((c[0] + c[1]) + (c[2] + c[3])) + ((d[0] + d[1]) + (d[2] + d[3])));
    return 1.0f / sqrtf(s * (1.0f / 1024.0f) + RMS_EPS);
}
struct EpiG3 {
    static constexpr bool PERM = true, AFTER_DRAIN = false;
    const float* ssq; bf16_t* Q; bf16_t* K; bf16_t* SZ;
    __device__ __forceinline__ void operator()(const f32x4 (&acc)[2][2][4][2], const pg8::Unit& u, int wr, int wc, int fr, int fq) const {
        const int row0 = u.pm * 256 + wr * 64 + fr; const bool gate = u.pn >= 8;
        const int colw = wc * 32 + 8 * fq; bf16_t* O; int ldc, col0;
        if (u.pn < 4) { O = Q; ldc = 1024; col0 = u.pn * 256 + colw; } else if (u.pn < 8) { O = K; ldc = 1024; col0 = (u.pn - 4) * 256 + colw; } else { O = SZ; ldc = 2048; col0 = (u.pn - 8) * 256 + colw; }
#pragma unroll
        for (int ai = 0; ai < 2; ++ai)
#pragma unroll
            for (int m = 0; m < 4; ++m) { const int row = row0 + ai * 128 + m * 16; const float s = inv_from_ssq(ssq, row); bf16_t* rowp = O + (size_t)row * ldc + col0;
#pragma unroll
                for (int bj = 0; bj < 2; ++bj) { f32x4 v0 = acc[ai][bj][m][0] * s, v1 = acc[ai][bj][m][1] * s;
                    if (gate) {
#pragma unroll
                        for (int e = 0; e < 4; ++e) { v0[e] = silu_f(v0[e]); v1[e] = silu_f(v1[e]); } }
                    u32x4 w; w.x = cvt_pk_bf16(v0[0], v0[1]); w.y = cvt_pk_bf16(v0[2], v0[3]); w.z = cvt_pk_bf16(v1[0], v1[1]); w.w = cvt_pk_bf16(v1[2], v1[3]);
                    *(u32x4*)(rowp + bj * 128) = w; } }
    }
};
struct EpiVT {
    static constexpr bool PERM = true, AFTER_DRAIN = false;
    const float* ssq; bf16_t* VT;
    __device__ __forceinline__ void operator()(const f32x4 (&acc)[2][2][4][2], const pg8::Unit& u, int wr, int wc, int fr, int fq) const {
        const int row0 = u.pm * 256 + wr * 64 + fr; const int tok0 = u.pn * 256 + wc * 32 + 8 * fq;
        const float myinv = inv_from_ssq(ssq, tok0 + 128 * (fr >> 3) + (fr & 7));
        const int lane = (int)(threadIdx.x & 63);
        float sc[2][8];
#pragma unroll
        for (int bj = 0; bj < 2; ++bj)
#pragma unroll
            for (int e = 0; e < 8; ++e) sc[bj][e] = __shfl(myinv, (lane & 48) | (bj * 8 + e));
        const int b = tok0 >> 11, s0 = tok0 & 2047;
#pragma unroll
        for (int ai = 0; ai < 2; ++ai)
#pragma unroll
            for (int m = 0; m < 4; ++m) { const int row = row0 + ai * 128 + m * 16; bf16_t* rowp = VT + ((size_t)b * 2048 + row) * 2048 + s0;
#pragma unroll
                for (int bj = 0; bj < 2; ++bj) { const f32x4 v0 = acc[ai][bj][m][0], v1 = acc[ai][bj][m][1]; u32x4 w;
                    w.x = cvt_pk_bf16(v0[0] * sc[bj][0], v0[1] * sc[bj][1]); w.y = cvt_pk_bf16(v0[2] * sc[bj][2], v0[3] * sc[bj][3]);
                    w.z = cvt_pk_bf16(v1[0] * sc[bj][4], v1[1] * sc[bj][5]); w.w = cvt_pk_bf16(v1[2] * sc[bj][6], v1[3] * sc[bj][7]);
                    *(u32x4*)(rowp + bj * 128) = w; } }
    }
};

__device__ __forceinline__ void tr_item(const float* W, int ld, int K, bf16_t* WT, int kb, int nsrc0, int ndst0, const float* kscale, float mul, LAS float* scr, int lane) {
    const int k0 = 64 * kb;
#pragma unroll 8
    for (int i = 0; i < 32; ++i) { const int kk = 2 * i + (lane >> 5); float v = W[(size_t)(k0 + kk) * ld + nsrc0 + (lane & 31)]; if (kscale) v *= kscale[k0 + kk]; scr[kk * 33 + (lane & 31)] = v * mul; }
    LDS_WAIT(); asm volatile("" ::: "memory");
    const int c = lane & 7;
#pragma unroll
    for (int j = 0; j < 4; ++j) { const int n = (lane >> 3) + 8 * j; const LAS float* s = scr + (8 * c) * 33 + n;
        u32x4 o; o.x = cvt_pk_bf16(s[0 * 33], s[1 * 33]); o.y = cvt_pk_bf16(s[2 * 33], s[3 * 33]); o.z = cvt_pk_bf16(s[4 * 33], s[5 * 33]); o.w = cvt_pk_bf16(s[6 * 33], s[7 * 33]);
        *(u32x4*)(WT + (size_t)(ndst0 + n) * K + k0 + 8 * c) = o; }
    LDS_WAIT(); asm volatile("" ::: "memory");
}
struct Args { const float* x; const float* norm_g; const float* pool_w_in; const float* pool_w; const float* pool_scale; const float* pool_w_out;
              const float* sb_w_in; const float* sb_w_out; const float* norm_f; float* out; unsigned char* ws; int ph_lo, ph_hi; };

__device__ __forceinline__ void prep_phase(const Args& a, LAS unsigned char* lds, int G, int lane, int wave) {
    unsigned char* ws = a.ws;
    bf16_t* W0T = (bf16_t*)(ws + WS_W0T); bf16_t* W0OT = (bf16_t*)(ws + WS_W0OT); bf16_t* W1T = (bf16_t*)(ws + WS_W1T); bf16_t* W1OT = (bf16_t*)(ws + WS_W1OT);
    bf16_t* FA = (bf16_t*)(ws + WS_FA); bf16_t* FB = (bf16_t*)(ws + WS_FB); float* INV0 = (float*)(ws + WS_INV0); bf16_t* XB = (bf16_t*)(ws + WS_XB);
    LAS float* scr = (LAS float*)(lds + wave * 16384);
    const int gw = blockIdx.x * 8 + wave, NGW = G * 8;
    constexpr int I1 = 16 * 64, I2 = 32 * 32, I3 = 16 * 192, I4 = 32 * 32, I5 = 4 * 8 * 16, NIT = I1 + I2 + I3 + I4 + I5;
    for (int it = gw; it < NIT; it += NGW) {
        int r = it;
        if (r < I1) { const int kb = r / 64, nb = r % 64; tr_item(a.pool_w_in, 4096, 1024, W0T, kb, 2048 + 32 * nb, 2048 + 32 * nb, a.norm_g, 1.f, scr, lane); continue; } r -= I1;
        if (r < I2) { const int kb = r / 32, nb = r % 32; tr_item(a.pool_w_out, 1024, 2048, W0OT, kb, 32 * nb, 32 * nb, nullptr, 1.f, scr, lane); continue; } r -= I2;
        if (r < I3) { const int kb = r / 192, nb = r % 192; const int ns = 32 * nb; const int nd = ns < 2048 ? ns : (ns < 4096 ? ns + 2048 : ns - 2048);
                      tr_item(a.sb_w_in, 6144, 1024, W1T, kb, ns, nd, a.norm_g + 1024, ns < 1024 ? QSCALE : 1.f, scr, lane); continue; } r -= I3;
        if (r < I4) { const int kb = r / 32, nb = r % 32; tr_item(a.sb_w_out, 1024, 2048, W1OT, kb, 32 * nb, 32 * nb, nullptr, 1.f, scr, lane); continue; } r -= I4;
        { const int g = r / 128, q = r % 128, kb = q / 16, nb = q % 16; tr_item(a.pool_w + (size_t)g * 512 * 512, 512, 512, FA, kb, 32 * nb, g * 512 + 32 * nb, nullptr, 1.f, scr, lane); }
    }
    for (int k = gw; k < 1024; k += NGW) { const float gk = a.norm_g[k]; const f32x4* src = (const f32x4*)(a.pool_w_in + (size_t)k * 4096);
#pragma unroll
        for (int j = 0; j < 8; ++j) { const int c = 4 * lane + 256 * j; const f32x4 v = src[lane + 64 * j] * gk; u32x2 w; w.x = cvt_pk_bf16(v[0], v[1]); w.y = cvt_pk_bf16(v[2], v[3]);
            *(u32x2*)(FB + ((size_t)(c >> 9) * 1024 + k) * 512 + (c & 511)) = w; } }
    for (int m = gw; m < MTOK; m += NGW) { const f32x4* xr = (const f32x4*)(a.x + (size_t)m * DM) + lane; f32x4 v[4]; float s = 0.f;
#pragma unroll
        for (int j = 0; j < 4; ++j) { v[j] = xr[64 * j]; s += (v[j][0] * v[j][0] + v[j][1] * v[j][1]) + (v[j][2] * v[j][2] + v[j][3] * v[j][3]); }
        s = wave_sum(s); if (lane == 0) INV0[m] = 1.0f / sqrtf(s * (1.0f / 1024.0f) + RMS_EPS);
        u32x2* o = (u32x2*)(XB + (size_t)m * DM) + lane;
#pragma unroll
        for (int j = 0; j < 4; ++j) { u32x2 w; w.x = cvt_pk_bf16(v[j][0], v[j][1]); w.y = cvt_pk_bf16(v[j][2], v[j][3]); o[64 * j] = w; } }
}

__device__ __forceinline__ void unpack8(const u32x4 w, float (&f)[8]) { f[0] = bf_lo(w.x); f[1] = bf_hi(w.x); f[2] = bf_lo(w.y); f[3] = bf_hi(w.y); f[4] = bf_lo(w.z); f[5] = bf_hi(w.z); f[6] = bf_lo(w.w); f[7] = bf_hi(w.w); }
__device__ __forceinline__ void pool_phase(const bf16_t* XM, const bf16_t* SZ, bf16_t* SZY, const float* scale, int G, int tid) {
    for (int task = blockIdx.x * 512 + tid; task < BATCH * 32 * 256; task += G * 512) {
        const int cc = task & 255, rc = (task >> 8) & 31, b = task >> 13, c0 = cc * 8, w = 2 << (c0 >> 9), ts = rc * 64;
        const size_t base = (size_t)b * SEQ * 2048 + c0;
        float sc[8]; { const f32x4 s0 = *(const f32x4*)(scale + c0), s1 = *(const f32x4*)(scale + c0 + 4); sc[0] = s0[0]; sc[1] = s0[1]; sc[2] = s0[2]; sc[3] = s0[3]; sc[4] = s1[0]; sc[5] = s1[1]; sc[6] = s1[2]; sc[7] = s1[3]; }
        float sum[8];
#pragma unroll
        for (int e = 0; e < 8; ++e) sum[e] = 0.f;
        for (int j = (ts - w + 1 > 0 ? ts - w + 1 : 0); j < ts; ++j) { float f[8]; unpack8(*(const u32x4*)(XM + base + (size_t)j * 2048), f);
#pragma unroll
            for (int e = 0; e < 8; ++e) sum[e] += f[e]; }
#pragma unroll 4
        for (int t = ts; t < ts + 64; ++t) {
            float cur[8], z[8], old[8]; unpack8(*(const u32x4*)(XM + base + (size_t)t * 2048), cur); unpack8(*(const u32x4*)(SZ + base + (size_t)t * 2048), z);
            const int jo = t - w + 1; const bool has_old = jo >= 0;
            unpack8(*(const u32x4*)(XM + base + (size_t)(has_old ? jo : 0) * 2048), old);
            const float rc_ = 1.0f / (float)(t + 1 < w ? t + 1 : w);
            float y[8];
#pragma unroll
            for (int e = 0; e < 8; ++e) { sum[e] += cur[e]; y[e] = (sum[e] * rc_ - cur[e]) * sc[e] * z[e]; sum[e] -= has_old ? old[e] : 0.f; }
            u32x4 o; o.x = cvt_pk_bf16(y[0], y[1]); o.y = cvt_pk_bf16(y[2], y[3]); o.z = cvt_pk_bf16(y[4], y[5]); o.w = cvt_pk_bf16(y[6], y[7]);
            *(u32x4*)(SZY + base + (size_t)t * 2048) = o;
        }
    }
}

__device__ __forceinline__ bf16x8 pack8(const float* a) { u32x4 w; w.x = cvt_pk_bf16(a[0], a[1]); w.y = cvt_pk_bf16(a[2], a[3]); w.z = cvt_pk_bf16(a[4], a[5]); w.w = cvt_pk_bf16(a[6], a[7]); return __builtin_bit_cast(bf16x8, w); }
template <bool DUMMY> __device__ __forceinline__ void attn_phase(const bf16_t* __restrict__ Q, const bf16_t* __restrict__ Kp, const bf16_t* __restrict__ VT, bf16_t* Y, bf16_t* XBd, int G, int lane, int wave) {
    const int n = lane & 31, hi = lane >> 5;
    const int pmr = (n & 19) | ((n & 4) << 1) | ((n & 8) >> 1);
    for (int u = blockIdx.x * 8 + wave; u < BATCH * NH * 64; u += G * 8) {
        const int bh = u >> 6, qb = u & 63, b = bh >> 4, h = bh & 15, t0 = qb * 32, t = t0 + n;
        const bf16_t* qrow = Q + (size_t)(b * SEQ + t) * 1024 + h * 64 + hi * 8;
        bf16x8 qf[4];
#pragma unroll
        for (int c = 0; c < 4; ++c) qf[c] = *(const bf16x8*)(qrow + 16 * c);
        const bf16_t* kbase = Kp + (size_t)(b * SEQ + pmr) * 1024 + h * 64 + hi * 8;
        const bf16_t* vbase = VT + ((size_t)b * 2048 + h * 128 + n) * 2048 + hi * 8;
        f32x16 o[4];
#pragma unroll
        for (int blk = 0; blk < 4; ++blk)
#pragma unroll
            for (int e = 0; e < 16; ++e) o[blk][e] = 0.f;
        float carry = 1.f;
        for (int kb = qb; kb >= 0; --kb) {
            const int key0 = kb * 32;
            const bf16_t* kr = kbase + (size_t)key0 * 1024;
            bf16x8 kf[4], vf[4][2];
#pragma unroll
            for (int c = 0; c < 4; ++c) kf[c] = *(const bf16x8*)(kr + 16 * c);
#pragma unroll
            for (int blk = 0; blk < 4; ++blk)
#pragma unroll
                for (int c = 0; c < 2; ++c) vf[blk][c] = *(const bf16x8*)(vbase + (size_t)blk * 32 * 2048 + key0 + 16 * c);
            f32x16 s;
#pragma unroll
            for (int e = 0; e < 16; ++e) s[e] = 0.f;
#pragma unroll
            for (int c = 0; c < 4; ++c) s = __builtin_amdgcn_mfma_f32_32x32x16_bf16(kf[c], qf[c], s, 0, 0, 0);
            float om[16], be[16], ex[16];
#pragma unroll
            for (int e = 0; e < 16; ++e) { const float ez = __builtin_amdgcn_exp2f(fminf(s[e], 120.f)); const float r = __builtin_amdgcn_rcpf(1.0f + ez); om[e] = r; be[e] = ez * r; }
            if (kb == qb) {
#pragma unroll
                for (int e = 0; e < 16; ++e) { const int key = key0 + 16 * (e >> 3) + 8 * hi + (e & 7); const bool v = key < t; om[e] = v ? om[e] : 1.f; be[e] = v ? be[e] : 0.f; } }
            float run = 1.f;
#pragma unroll
            for (int e = 7; e >= 0; --e) { ex[e] = run; run *= om[e]; }
            const float pA = run; run = 1.f;
#pragma unroll
            for (int e = 15; e >= 8; --e) { ex[e] = run; run *= om[e]; }
            const float pB = run;
            const float pAo = __shfl_xor(pA, 32), pBo = __shfl_xor(pB, 32);
            const float mB = (hi ? 1.f : pBo) * carry;
            const float mA = (hi ? pB * pBo : pAo * pB * pBo) * carry;
            float av[16];
#pragma unroll
            for (int e = 0; e < 16; ++e) av[e] = be[e] * ex[e] * (e < 8 ? mA : mB);
            carry *= (pA * pAo) * (pB * pBo);
            const bf16x8 pf0 = pack8(av), pf1 = pack8(av + 8);
#pragma unroll
            for (int blk = 0; blk < 4; ++blk) { o[blk] = __builtin_amdgcn_mfma_f32_32x32x16_bf16(vf[blk][0], pf0, o[blk], 0, 0, 0); o[blk] = __builtin_amdgcn_mfma_f32_32x32x16_bf16(vf[blk][1], pf1, o[blk], 0, 0, 0); }
            if (__all(carry < 1e-30f)) break;
        }
        bf16_t* yrow = Y + (size_t)(b * SEQ + t) * 2048 + h * 128 + 4 * hi;
#pragma unroll
        for (int blk = 0; blk < 4; ++blk)
#pragma unroll
            for (int i = 0; i < 4; ++i) { u32x2* p = (u32x2*)(yrow + 32 * blk + 8 * i); const u32x2 z = *p; u32x2 w; if (DUMMY) p = (u32x2*)(XBd + ((size_t)(p - (u32x2*)Y) * 4 & (size_t)(32 * 1048576 - 1)));
                w.x = cvt_pk_bf16(o[blk][4 * i + 0] * bf_lo(z.x), o[blk][4 * i + 1] * bf_hi(z.x)); w.y = cvt_pk_bf16(o[blk][4 * i + 2] * bf_lo(z.y), o[blk][4 * i + 3] * bf_hi(z.y)); *p = w; }
    }
}

#define XB_TMO      128
#define XB_XCNT(j)  (256  + 64 * (j))
#define XB_XSUB(j)  (1280 + 64 * (j))
#define XB_XGEN(j)  (2304 + 64 * (j))
#define XB_TOP      3328
#define XB_TOPGEN   3392
#define XCD_BAR_WORDS 3456
#define XB_SPIN_CAP (1u << 18)

__device__ __forceinline__ unsigned xb_ld(unsigned* p)              { return __hip_atomic_load(p, __ATOMIC_RELAXED, __HIP_MEMORY_SCOPE_AGENT); }
__device__ __forceinline__ unsigned xb_add(unsigned* p, unsigned v) { return __hip_atomic_fetch_add(p, v, __ATOMIC_RELAXED, __HIP_MEMORY_SCOPE_AGENT); }
__device__ __forceinline__ unsigned xb_xcc_id() { return (unsigned)__builtin_amdgcn_s_getreg((3 << 11) | 20) & 0xFu; }
#define XB_SPIN(cond, bar) do { unsigned _sp = 0; while (cond) { __builtin_amdgcn_s_sleep(1); \
    if ((++_sp & 255u) == 0u) { if (xb_ld(&(bar)[XB_TMO])) break; if (_sp > XB_SPIN_CAP) { atomicAdd(&(bar)[XB_TMO], 1u); break; } } } } while (0)

struct XcdBarrier {
    unsigned* bar; unsigned x;
    volatile LAS unsigned* st;
};

__device__ __forceinline__ XcdBarrier xcd_barrier_post(unsigned* bar, volatile LAS unsigned* st) {
    XcdBarrier b; b.bar = bar; b.x = xb_xcc_id(); b.st = st;
    if (threadIdx.x == 0) (void)xb_add(&bar[XB_XCNT(b.x)], 1u);
    return b;
}
__device__ __forceinline__ void xcd_barrier_complete(unsigned* bar, unsigned x, unsigned& nloc, unsigned& nx) {
    const unsigned G = gridDim.x * gridDim.y * gridDim.z;
    unsigned sum, cnt, mine, sp = 0u;
    for (;;) {
        sum = 0u; cnt = 0u; mine = 0u;
#pragma unroll
        for (unsigned j = 0; j < 16; ++j) { const unsigned c = xb_ld(&bar[XB_XCNT(j)]); sum += c; cnt += (c > 0u) ? 1u : 0u; mine = (j == x) ? c : mine; }
        if (sum == G) break;
        __builtin_amdgcn_s_sleep(1);
        if ((++sp & 255u) == 0u) { if (xb_ld(&bar[XB_TMO])) break; if (sp > XB_SPIN_CAP) { atomicAdd(&bar[XB_TMO], 1u); break; } }
    }
    nloc = mine > 0u ? mine : 1u; nx = cnt > 0u ? cnt : 1u;
}

__device__ __forceinline__ void xcd_barrier(const XcdBarrier& b) {
    asm volatile("s_waitcnt vmcnt(0)" ::: "memory");
    __syncthreads();
    if (threadIdx.x == 0) {
        unsigned* bar = b.bar;
        __builtin_amdgcn_s_waitcnt(0);
        unsigned nloc = b.st[0], nx = b.st[1];
        if (nloc == 0u) { xcd_barrier_complete(bar, b.x, nloc, nx); b.st[0] = nloc; b.st[1] = nx; }
        const unsigned old = xb_add(&bar[XB_XSUB(b.x)], 1u);
        const unsigned gen = old / nloc;
        if (old + 1u == (gen + 1u) * nloc) {
            __builtin_amdgcn_fence(__ATOMIC_RELEASE, "agent");
            asm volatile("s_waitcnt vmcnt(0)" ::: "memory");
            const unsigned og = xb_add(&bar[XB_TOP], 1u);
            const unsigned tg = og / nx;
            if (og + 1u == (tg + 1u) * nx) xb_add(&bar[XB_TOPGEN], 1u);
            else XB_SPIN(xb_ld(&bar[XB_TOPGEN]) == tg, bar);
            __builtin_amdgcn_fence(__ATOMIC_ACQUIRE, "agent");
            xb_add(&bar[XB_XGEN(b.x)], 1u);
            asm volatile("s_waitcnt vmcnt(0)" ::: "memory");
        } else {
            XB_SPIN(xb_ld(&bar[XB_XGEN(b.x)]) == gen, bar);
            __builtin_amdgcn_fence(__ATOMIC_ACQUIRE, "agent");
            asm volatile("s_waitcnt vmcnt(0)" ::: "memory");
        }
    }
    __syncthreads();
}

__global__ void __launch_bounds__(512, 2) mk_fwd(Args a) {
    extern __shared__ __attribute__((aligned(16))) unsigned char lds_raw[];
    cg::grid_group grid = cg::this_grid();
    LAS unsigned char* lds = (LAS unsigned char*)lds_raw;
    const int tid = threadIdx.x, lane = tid & 63, wave = __builtin_amdgcn_readfirstlane(tid >> 6), G = gridDim.x;
    unsigned char* ws = a.ws;
    bf16_t* W0T = (bf16_t*)(ws + WS_W0T); bf16_t* W0OT = (bf16_t*)(ws + WS_W0OT); bf16_t* W1T = (bf16_t*)(ws + WS_W1T); bf16_t* W1OT = (bf16_t*)(ws + WS_W1OT);
    bf16_t* FA = (bf16_t*)(ws + WS_FA); bf16_t* FB = (bf16_t*)(ws + WS_FB); float* INV0 = (float*)(ws + WS_INV0); float* SSQ1 = (float*)(ws + WS_SSQ1); float* SSQ2 = (float*)(ws + WS_SSQ2);
    bf16_t* XB = (bf16_t*)(ws + WS_XB); bf16_t* RA = (bf16_t*)(ws + WS_A); bf16_t* RB = (bf16_t*)(ws + WS_B); bf16_t* RC = (bf16_t*)(ws + WS_C);
    const int lo = a.ph_lo, hi = a.ph_hi;
    volatile LAS unsigned* MISC = (volatile LAS unsigned*)(lds + MISC_OFF);
    if (tid < 64) MISC[tid] = 0u;
    __syncthreads();
    if (lo < 0) grid.sync();
    const XcdBarrier bar = xcd_barrier_post((unsigned*)(ws + WS_CTL), MISC);
#define IN(k) (lo <= (k) && (k) < hi)
#define SEAM(k) do { if (IN(k) && IN((k) + 1)) xcd_barrier(bar); } while (0)
    constexpr int NOGRP = 30;
    if (MK_PROBE & 256) { for (int i = 0; i < 16; ++i) grid.sync(); }
    if (MK_PROBE & 512) { const int gw = blockIdx.x * 8 + wave, NGW = G * 8; for (int m = gw; m < MTOK; m += NGW) { const float inv = 1.0f + SSQ2[m]; const f32x4* r = (const f32x4*)(a.x + (size_t)m * DM) + lane; f32x4* w = (f32x4*)((float*)RA + (size_t)m * DM) + lane;
        for (int j = 0; j < 4; ++j) w[64 * j] = r[64 * j] * inv; } }
    if (IN(0)) { prep_phase(a, lds, G, lane, wave); __syncthreads(); if (MK_PROBE & 1) { prep_phase(a, lds, G, lane, wave); __syncthreads(); } }
    SEAM(0);
    if (IN(1)) { pg8::Gemm g{FA, FB, 2048, 1024, 512, 1, (size_t)1024 * 512 * 2}; pg8::StaticOrder S; S.init(2048, 1024, G, (int)blockIdx.x);
        EpiStore E{W0T, 1024}; pg8::gemm_phase<EpiStore, pg8::StaticOrder, true, true>(lds, g, S, E); if (MK_PROBE & 2) pg8::gemm_phase<EpiStore, pg8::StaticOrder, true, true>(lds, g, S, E); }
    SEAM(1);
    if (IN(2)) { pg8::Gemm g{XB, W0T, MTOK, 4096, 1024, NOGRP, 0}; pg8::StaticOrder S; S.init(MTOK, 4096, G, (int)blockIdx.x);
        EpiG1 E{INV0, RA, RB}; pg8::gemm_phase<EpiG1, pg8::StaticOrder, true, true>(lds, g, S, E); if (MK_PROBE & 4) pg8::gemm_phase<EpiG1, pg8::StaticOrder, true, true>(lds, g, S, E); }
    SEAM(2);
    if (IN(3)) { if (MK_PROBE & 8) pool_phase(RA, RB, RC, a.pool_scale, G, tid); pool_phase(RA, RB, RB, a.pool_scale, G, tid); }
    SEAM(3);
    if (IN(4)) { pg8::Gemm g{RB, W0OT, MTOK, 1024, 2048, NOGRP, 0}; pg8::StaticOrder S; S.init(MTOK, 1024, G, (int)blockIdx.x);
        EpiRes E{a.x, a.out, XB, SSQ1}; pg8::gemm_phase<EpiRes, pg8::StaticOrder, true, true>(lds, g, S, E); if (MK_PROBE & 16) pg8::gemm_phase<EpiRes, pg8::StaticOrder, true, true>(lds, g, S, E); }
    SEAM(4);
    if (IN(5)) {
        { pg8::Gemm g{XB, W1T, MTOK, 4096, 1024, NOGRP, 0}; pg8::StaticOrder S; S.init(MTOK, 4096, G, (int)blockIdx.x);
          EpiG3 E{SSQ1, RA, RA + (size_t)MTOK * 1024, RC}; pg8::gemm_phase<EpiG3, pg8::StaticOrder, true, true>(lds, g, S, E); if (MK_PROBE & 32) pg8::gemm_phase<EpiG3, pg8::StaticOrder, true, true>(lds, g, S, E); }
        { pg8::Gemm g{W1T + (size_t)4096 * 1024, XB, 2048, MTOK, 1024, NOGRP, 0}; pg8::StaticOrder S; S.init(2048, MTOK, G, (int)blockIdx.x);
          EpiVT E{SSQ1, RB}; pg8::gemm_phase<EpiVT, pg8::StaticOrder, true, true>(lds, g, S, E); if (MK_PROBE & 32) pg8::gemm_phase<EpiVT, pg8::StaticOrder, true, true>(lds, g, S, E); }
    }
    SEAM(5);
    if (IN(6)) { if (MK_PROBE & 64) attn_phase<true>(RA, RA + (size_t)MTOK * 1024, RB, RC, XB, G, lane, wave); attn_phase<false>(RA, RA + (size_t)MTOK * 1024, RB, RC, XB, G, lane, wave); }
    SEAM(6);
    if (IN(7)) { pg8::Gemm g{RC, W1OT, MTOK, 1024, 2048, NOGRP, 0}; pg8::StaticOrder S; S.init(MTOK, 1024, G, (int)blockIdx.x);
        if (MK_PROBE & 128) { EpiRes E2{a.x, (float*)RA, nullptr, SSQ2}; pg8::gemm_phase<EpiRes, pg8::StaticOrder, true, true>(lds, g, S, E2); }
        EpiRes E{a.out, a.out, nullptr, SSQ2}; pg8::gemm_phase<EpiRes, pg8::StaticOrder, true, true>(lds, g, S, E); }
    SEAM(7);
    if (IN(8)) { const int gw = blockIdx.x * 8 + wave, NGW = G * 8;
        f32x4 gf[4];
#pragma unroll
        for (int j = 0; j < 4; ++j) gf[j] = ((const f32x4*)a.norm_f)[lane + 64 * j];
        for (int m = gw; m < MTOK; m += NGW) { const float inv = inv_from_ssq(SSQ2, m); f32x4* r = (f32x4*)(a.out + (size_t)m * DM) + lane;
#pragma unroll
            for (int j = 0; j < 4; ++j) r[64 * j] = r[64 * j] * inv * gf[j]; } }
#undef IN
#undef SEAM
}

extern "C" void kernel_launch(void* const* d_in, const int* in_sizes, int n_in, void* d_out, int out_size, void* d_ws, size_t ws_size, hipStream_t stream) {
    static int grid = 0;
    if (grid == 0) {
        if (n_in != 9 || in_sizes[0] != MTOK * DM || out_size != MTOK * DM || ws_size < WS_END) { fprintf(stderr, "kernel_launch: unexpected shapes (n_in %d, in0 %d, out %d, ws %zu)\n", n_in, n_in > 0 ? in_sizes[0] : -1, out_size, ws_size); grid = -1; return; }
        int dev = 0, cus = 0, per_cu = 0;
        (void)hipGetDevice(&dev); (void)hipDeviceGetAttribute(&cus, hipDeviceAttributeMultiprocessorCount, dev);
        if (hipFuncSetAttribute((const void*)mk_fwd, hipFuncAttributeMaxDynamicSharedMemorySize, LDS_BYTES) != hipSuccess) { fprintf(stderr, "kernel_launch: hipFuncSetAttribute failed\n"); grid = -1; return; }
        if (hipOccupancyMaxActiveBlocksPerMultiprocessor(&per_cu, (const void*)mk_fwd, 512, LDS_BYTES) != hipSuccess || per_cu < 1) { fprintf(stderr, "kernel_launch: occupancy query failed (%d)\n", per_cu); (void)hipGetLastError(); per_cu = 1; }
        if (per_cu > 1) per_cu = 1;
        grid = cus * per_cu;
        if (grid <= 0) { grid = -1; return; }
    }
    if (grid < 0) return;
    Args a{};
    a.x = (const float*)d_in[0]; a.norm_g = (const float*)d_in[1]; a.pool_w_in = (const float*)d_in[2]; a.pool_w = (const float*)d_in[3]; a.pool_scale = (const float*)d_in[4];
    a.pool_w_out = (const float*)d_in[5]; a.sb_w_in = (const float*)d_in[6]; a.sb_w_out = (const float*)d_in[7]; a.norm_f = (const float*)d_in[8];
    a.out = (float*)d_out; a.ws = (unsigned char*)d_ws;
    if (hipMemsetAsync((char*)d_ws + WS_CTL, 0, CTL_BYTES, stream) != hipSuccess) { fprintf(stderr, "kernel_launch: memset of the barrier words failed\n"); return; }
#if MK_SPLIT
    for (int p = 0; p < NPHASE; ++p) { a.ph_lo = p; a.ph_hi = p + 1; void* args[] = {&a};
        hipError_t e = hipLaunchCooperativeKernel((const void*)mk_fwd, dim3(grid), dim3(512), args, LDS_BYTES, stream);
        if (e != hipSuccess) { fprintf(stderr, "kernel_launch: cooperative launch (phase %d) failed: %s (grid %d)\n", p, hipGetErrorString(e), grid); break; } }
#else
    a.ph_lo = 0; a.ph_hi = NPHASE; void* args[] = {&a};
    hipError_t e = hipLaunchCooperativeKernel((const void*)mk_fwd, dim3(grid), dim3(512), args, LDS_BYTES, stream);
    if (e != hipSuccess) fprintf(stderr, "kernel_launch: cooperative launch failed: %s (grid %d)\n", hipGetErrorString(e), grid);
#endif
}
```

```cpp
#include <hip/hip_runtime.h>
#include <hip/hip_cooperative_groups.h>
#include <cstdio>
#include <cstdint>
namespace cg = cooperative_groups;
namespace pg8 {
#define PG8_LAS __attribute__((address_space(3)))
typedef unsigned short bf16_t;
typedef short bf16x8 __attribute__((ext_vector_type(8)));
typedef float f32x4 __attribute__((ext_vector_type(4)));
typedef unsigned u32x4 __attribute__((ext_vector_type(4)));
constexpr int BM = 256, BK = 64, HALF = 128, HTB = HALF * BK * 2  , STAGE_BYTES = 8 * HTB, NXCD = 8, WGM = 8;

__host__ __device__ __forceinline__ int lds_byte(int r, int c) { const int st = (r >> 4) * 2 + (c >> 5), rr = r & 15, cc = c & 31, ob = rr * 64 + cc * 2; return st * 1024 + (ob ^ (((ob >> 9) & 1) << 5)); }
__host__ __device__ __forceinline__ void stage_rc(int b, int& R, int& C) { const int st = b / 1024, sb = b % 1024, swz = sb ^ (((sb >> 9) & 1) << 5); R = (st >> 1) * 16 + swz / 64; C = (st & 1) * 32 + (swz % 64) / 2; }
__host__ __device__ __forceinline__ int perm32(int rho) { const int n = rho >> 4, i = rho & 15; return 8 * (i >> 2) + 4 * n + (i & 3); }

struct Unit { int pm, pn; };
struct Gemm { const bf16_t* A; const bf16_t* Bt; int M, N, K; int gshift; size_t gstride; };

struct StaticOrder {
    int nM, nN, nwg, G, c;
    __host__ __device__ void init(int M, int N, int G_, int c_) { nM = M / BM; nN = N / BM; nwg = nM * nN; G = G_; c = c_; }
    __host__ __device__ bool next(int i, Unit& u) const {
        const long L = (long)i * G + c; if (L >= nwg) return false;
        int wgid = (int)L; { const int q = nwg / NXCD, r = nwg % NXCD, xcd = wgid % NXCD, off = wgid / NXCD; wgid = (xcd < r ? xcd * (q + 1) : r * (q + 1) + (xcd - r) * q) + off; }
        const int nig = WGM * nN, gid = wgid / nig, fm = gid * WGM, gsz = (nM - fm) < WGM ? (nM - fm) : WGM;
        u.pm = fm + ((wgid % nig) % gsz); u.pn = (wgid % nig) / gsz; return true;
    }
    __device__ __forceinline__ void a_ready(const Unit&) const {}
    __device__ __forceinline__ void done(const Unit&) const {}
};

__device__ __forceinline__ unsigned cvt_pk_bf16(float lo, float hi) { unsigned r; asm volatile("v_cvt_pk_bf16_f32 %0, %1, %2" : "=v"(r) : "v"(lo), "v"(hi)); return r; }

template <class Epi, class Sched, bool ALIGN_EPI = false, bool SP2 = false>
__device__ __forceinline__ void gemm_phase(PG8_LAS unsigned char* lds, const Gemm g, const Sched& S, const Epi& E) {
    const int tid = threadIdx.x, wid = __builtin_amdgcn_readfirstlane(tid >> 6), lane = tid & 63, wr = wid >> 2, wc = wid & 3, fr = lane & 15, fq = lane >> 4;
    const int K = g.K, nt = K / BK;
    unsigned voffA[2], voffB[2];
#pragma unroll
    for (int i = 0; i < 2; ++i) { int R, C; stage_rc(tid * 16 + i * 8192, R, C); const int Rb = Epi::PERM ? ((R & ~31) + perm32(R & 31)) : R;
        voffA[i] = (unsigned)(R * K + C) * 2u; voffB[i] = (unsigned)(Rb * K + C) * 2u; }
    const size_t kstep = (size_t)(BK * 2);
    const size_t hstep = (size_t)HALF * K * 2;
    const size_t tstep = 2 * hstep;
    const unsigned ldsw = (unsigned)wid * 1024u;
    const int aoff = lds_byte(wr * 64 + fr, fq * 8), boff = lds_byte(wc * 32 + fr, fq * 8);
#define PG8_SA(b, h) (((b) * 2 + (h)) * HTB)
#define PG8_SB(b, h) ((4 + (b) * 2 + (h)) * HTB)
#define PG8_STAGE(bufoff, gbase, voff) do { _Pragma("unroll") for (int _i = 0; _i < 2; ++_i) \
        __builtin_amdgcn_global_load_lds((const unsigned*)((const char*)(gbase) + (voff)[_i]), (PG8_LAS unsigned*)(lds + (bufoff) + ldsw + _i * 8192), 16, 0, 0); } while (0)
#define PG8_LDA(dst, b, h) do { _Pragma("unroll") for (int m = 0; m < 4; ++m) _Pragma("unroll") for (int k = 0; k < 2; ++k) dst[m][k] = *(const PG8_LAS bf16x8*)(lds + PG8_SA(b, h) + aoff + m * 2048 + k * 1024); } while (0)
#define PG8_LDB(dst, b, h) do { _Pragma("unroll") for (int n = 0; n < 2; ++n) _Pragma("unroll") for (int k = 0; k < 2; ++k) dst[n][k] = *(const PG8_LAS bf16x8*)(lds + PG8_SB(b, h) + boff + n * 2048 + k * 1024); } while (0)
#define PG8_MMA(ai, bj, At, Bt) do { __builtin_amdgcn_s_setprio(1); _Pragma("unroll") for (int m = 0; m < 4; ++m) _Pragma("unroll") for (int n = 0; n < 2; ++n) _Pragma("unroll") for (int k = 0; k < 2; ++k) \
        acc[ai][bj][m][n] = __builtin_amdgcn_mfma_f32_16x16x32_bf16(Bt[n][k], At[m][k], acc[ai][bj][m][n], 0, 0, 0); __builtin_amdgcn_s_setprio(0); } while (0)
#define PG8_WAIT_V(n) asm volatile("s_waitcnt vmcnt(" #n ")" ::: "memory")
#define PG8_WAIT_L(n) asm volatile("s_waitcnt lgkmcnt(" #n ")" ::: "memory")
#define PG8_BAR __builtin_amdgcn_s_barrier()
#define PG8_SCHED __builtin_amdgcn_sched_barrier(0)
    Unit cur, nxt; int ui = 0;
    if (!S.next(0, cur)) return;
    f32x4 acc[2][2][4][2];
#pragma unroll
    for (int a = 0; a < 2; ++a)
#pragma unroll
        for (int b = 0; b < 2; ++b)
#pragma unroll
            for (int m = 0; m < 4; ++m)
#pragma unroll
                for (int n = 0; n < 2; ++n) acc[a][b][m][n] = (f32x4){0.f, 0.f, 0.f, 0.f};
    bf16x8 At[4][2], B0[2][2], B1[2][2];
    const char* cA = (const char*)g.A + (size_t)cur.pm * tstep; const char* cB = (const char*)g.Bt + (size_t)(cur.pm >> g.gshift) * g.gstride + (size_t)cur.pn * tstep;
    S.a_ready(cur);
    if constexpr (SP2) {
        PG8_STAGE(PG8_SB(0, 0), cB, voffB); PG8_STAGE(PG8_SB(0, 1), cB + hstep, voffB); PG8_STAGE(PG8_SA(0, 0), cA, voffA); PG8_STAGE(PG8_SA(0, 1), cA + hstep, voffA);
        if (wr == 1) PG8_BAR;
        PG8_WAIT_V(2); PG8_BAR;
        PG8_STAGE(PG8_SB(1, 0), cB + kstep, voffB); PG8_STAGE(PG8_SA(1, 0), cA + kstep, voffA); PG8_STAGE(PG8_SB(1, 1), cB + hstep + kstep, voffB);
        PG8_WAIT_V(6); PG8_BAR;
    } else {
        PG8_STAGE(PG8_SB(0, 0), cB, voffB); PG8_STAGE(PG8_SA(0, 0), cA, voffA); PG8_STAGE(PG8_SB(0, 1), cB + hstep, voffB); PG8_STAGE(PG8_SA(0, 1), cA + hstep, voffA);
        if (wr == 1) PG8_BAR;
        PG8_WAIT_V(4); PG8_BAR;
        PG8_STAGE(PG8_SB(1, 0), cB + kstep, voffB); PG8_STAGE(PG8_SA(1, 0), cA + kstep, voffA); PG8_STAGE(PG8_SB(1, 1), cB + hstep + kstep, voffB);
        PG8_WAIT_V(6); PG8_BAR;
    }
    for (;;) {
        const bool has_next = S.next(ui + 1, nxt);
        const char* nA = has_next ? (const char*)g.A + (size_t)nxt.pm * tstep : cA; const char* nB = has_next ? (const char*)g.Bt + (size_t)(nxt.pm >> g.gshift) * g.gstride + (size_t)nxt.pn * tstep : cB;
        for (int t = 0; t < nt; t += 2) {
            const bool last = (t == nt - 2);
            const char* a1 = cA + (size_t)(t + 1) * kstep;
            const char* a2 = last ? nA : cA + (size_t)(t + 2) * kstep; const char* b2 = last ? nB : cB + (size_t)(t + 2) * kstep;
            const char* a3 = a2 + kstep; const char* b3 = b2 + kstep;
            if (last && has_next) S.a_ready(nxt);
            if constexpr (SP2) {
            PG8_LDB(B0, 0, 0); PG8_LDB(B1, 0, 1); PG8_SCHED; PG8_LDA(At, 0, 0); PG8_STAGE(PG8_SA(1, 1), a1 + hstep, voffA);
            PG8_WAIT_V(8); PG8_WAIT_L(0); PG8_BAR; PG8_MMA(0, 0, At, B0); PG8_MMA(0, 1, At, B1); PG8_BAR; PG8_SCHED;
            PG8_LDA(At, 0, 1); PG8_STAGE(PG8_SB(0, 0), b2, voffB); PG8_STAGE(PG8_SB(0, 1), b2 + hstep, voffB); PG8_STAGE(PG8_SA(0, 0), a2, voffA);
            PG8_WAIT_V(8); PG8_WAIT_L(0); PG8_BAR; PG8_MMA(1, 0, At, B0); PG8_MMA(1, 1, At, B1); PG8_BAR; PG8_SCHED;
            PG8_LDB(B0, 1, 0); PG8_LDB(B1, 1, 1); PG8_SCHED; PG8_LDA(At, 1, 0); PG8_STAGE(PG8_SA(0, 1), a2 + hstep, voffA);
            PG8_WAIT_V(8); PG8_WAIT_L(0); PG8_BAR; PG8_MMA(0, 0, At, B0); PG8_MMA(0, 1, At, B1); PG8_BAR; PG8_SCHED;
            PG8_LDA(At, 1, 1); PG8_STAGE(PG8_SB(1, 0), b3, voffB); PG8_STAGE(PG8_SB(1, 1), b3 + hstep, voffB); PG8_STAGE(PG8_SA(1, 0), a3, voffA);
            PG8_WAIT_V(8); PG8_WAIT_L(0); PG8_BAR; PG8_MMA(1, 0, At, B0); PG8_MMA(1, 1, At, B1); PG8_BAR; PG8_SCHED;
            } else {
            PG8_LDB(B0, 0, 0); PG8_SCHED; PG8_LDA(At, 0, 0); PG8_STAGE(PG8_SA(1, 1), a1 + hstep, voffA);
            PG8_WAIT_L(8); PG8_BAR; PG8_WAIT_L(0); PG8_MMA(0, 0, At, B0); PG8_BAR; PG8_SCHED;
            PG8_LDB(B1, 0, 1); PG8_STAGE(PG8_SB(0, 0), b2, voffB);
            PG8_BAR; PG8_WAIT_L(0); PG8_MMA(0, 1, At, B1); PG8_BAR;
            PG8_LDA(At, 0, 1); PG8_STAGE(PG8_SA(0, 0), a2, voffA);
            PG8_BAR; PG8_WAIT_L(0); PG8_MMA(1, 0, At, B0); PG8_BAR; PG8_SCHED;
            PG8_STAGE(PG8_SB(0, 1), b2 + hstep, voffB);
            PG8_WAIT_V(6); PG8_BAR; PG8_MMA(1, 1, At, B1); PG8_BAR;
            PG8_LDB(B0, 1, 0); PG8_SCHED; PG8_LDA(At, 1, 0); PG8_STAGE(PG8_SA(0, 1), a2 + hstep, voffA);
            PG8_WAIT_L(8); PG8_BAR; PG8_WAIT_L(0); PG8_MMA(0, 0, At, B0); PG8_BAR; PG8_SCHED;
            PG8_LDB(B1, 1, 1); PG8_STAGE(PG8_SB(1, 0), b3, voffB);
            PG8_BAR; PG8_WAIT_L(0); PG8_MMA(0, 1, At, B1); PG8_BAR;
            PG8_LDA(At, 1, 1); PG8_STAGE(PG8_SA(1, 0), a3, voffA);
            PG8_BAR; PG8_WAIT_L(0); PG8_MMA(1, 0, At, B0); PG8_BAR; PG8_SCHED;
            PG8_STAGE(PG8_SB(1, 1), b3 + hstep, voffB);
            PG8_WAIT_V(6); PG8_BAR; PG8_MMA(1, 1, At, B1); PG8_BAR;
            }
        }
        if constexpr (ALIGN_EPI) { if (wr == 0) PG8_BAR; }
        if constexpr (!Epi::AFTER_DRAIN) { E(acc, cur, wr, wc, fr, fq); S.done(cur); }
        if (!has_next) break;
#pragma unroll
        for (int a = 0; a < 2; ++a)
#pragma unroll
            for (int b = 0; b < 2; ++b)
#pragma unroll
                for (int m = 0; m < 4; ++m)
#pragma unroll
                    for (int n = 0; n < 2; ++n) acc[a][b][m][n] = (f32x4){0.f, 0.f, 0.f, 0.f};
        cur = nxt; cA = nA; cB = nB; ++ui;
        if constexpr (ALIGN_EPI) { if (wr == 1) PG8_BAR; }
    }
    PG8_WAIT_V(0);
    if constexpr (!ALIGN_EPI) { if (wr == 0) PG8_BAR; }
    PG8_BAR;
    if constexpr (Epi::AFTER_DRAIN) { E.fused(acc, cur, wr, wc, fr, fq, lds, wid, lane); S.done(cur); }
#undef PG8_SA
#undef PG8_SB
#undef PG8_STAGE
#undef PG8_LDA
#undef PG8_LDB
#undef PG8_MMA
#undef PG8_WAIT_V
#undef PG8_WAIT_L
#undef PG8_BAR
#undef PG8_SCHED
}
}

#ifndef MK_PROBE
#define MK_PROBE 0
#endif
#ifndef MK_SPLIT
#define MK_SPLIT 0
#endif
constexpr int DM = 1024, BATCH = 16, SEQ = 2048, MTOK = BATCH * SEQ, DI = 2048, NH = 16, DK = 64, DV = 128;
constexpr float RMS_EPS = 1e-6f;
constexpr float QSCALE = 0.125f * 1.4426950408889634f;
constexpr int NPHASE = 9;
constexpr size_t MiB = 1u << 20;
constexpr size_t WS_W0T = 0;
constexpr size_t WS_W0OT = 8 * MiB;
constexpr size_t WS_W1T = 12 * MiB;
constexpr size_t WS_W1OT = 24 * MiB;
constexpr size_t WS_FA = 28 * MiB;
constexpr size_t WS_FB = 30 * MiB;
constexpr size_t WS_INV0 = 34 * MiB;
constexpr size_t WS_SSQ1 = 35 * MiB;
constexpr size_t WS_SSQ2 = 37 * MiB;
constexpr size_t WS_CTL = 39 * MiB, CTL_BYTES = 16384;
constexpr size_t WS_XB = 40 * MiB;
constexpr size_t WS_A = 104 * MiB;
constexpr size_t WS_B = 232 * MiB;
constexpr size_t WS_C = 360 * MiB;
constexpr size_t WS_END = 488 * MiB;
constexpr int MISC_OFF = 131072;
constexpr int LDS_BYTES = 147456;

#define LAS __attribute__((address_space(3)))
typedef unsigned short bf16_t;
typedef short bf16x8 __attribute__((ext_vector_type(8)));
typedef float f32x4 __attribute__((ext_vector_type(4)));
typedef float f32x16 __attribute__((ext_vector_type(16)));
typedef unsigned u32x4 __attribute__((ext_vector_type(4)));
typedef unsigned u32x2 __attribute__((ext_vector_type(2)));
using pg8::cvt_pk_bf16;
#define LDS_WAIT() asm volatile("s_waitcnt lgkmcnt(0)" ::: "memory")

__device__ __forceinline__ float bf_lo(unsigned w) { return __uint_as_float(w << 16); }
__device__ __forceinline__ float bf_hi(unsigned w) { return __uint_as_float(w & 0xffff0000u); }
__device__ __forceinline__ float silu_f(float v) { return v * __builtin_amdgcn_rcpf(1.0f + __builtin_amdgcn_exp2f(-1.4426950408889634f * v)); }
__device__ __forceinline__ float wave_sum(float v) {
#pragma unroll
    for (int o = 1; o < 64; o <<= 1) v += __shfl_xor(v, o);
    return v;
}

struct EpiStore {
    static constexpr bool PERM = true, AFTER_DRAIN = false;
    bf16_t* O; int ldc;
    __device__ __forceinline__ void operator()(const f32x4 (&acc)[2][2][4][2], const pg8::Unit& u, int wr, int wc, int fr, int fq) const {
        const int row0 = u.pm * 256 + wr * 64 + fr, col0 = u.pn * 256 + wc * 32 + 8 * fq;
#pragma unroll
        for (int ai = 0; ai < 2; ++ai)
#pragma unroll
            for (int m = 0; m < 4; ++m) { bf16_t* rowp = O + (size_t)(row0 + ai * 128 + m * 16) * ldc + col0;
#pragma unroll
                for (int bj = 0; bj < 2; ++bj) { const f32x4 v0 = acc[ai][bj][m][0], v1 = acc[ai][bj][m][1]; u32x4 w;
                    w.x = cvt_pk_bf16(v0[0], v0[1]); w.y = cvt_pk_bf16(v0[2], v0[3]); w.z = cvt_pk_bf16(v1[0], v1[1]); w.w = cvt_pk_bf16(v1[2], v1[3]);
                    *(u32x4*)(rowp + bj * 128) = w; } }
    }
};
struct EpiG1 {
    static constexpr bool PERM = true, AFTER_DRAIN = false;
    const float* inv; bf16_t* XM; bf16_t* SZ;
    __device__ __forceinline__ void operator()(const f32x4 (&acc)[2][2][4][2], const pg8::Unit& u, int wr, int wc, int fr, int fq) const {
        const int row0 = u.pm * 256 + wr * 64 + fr; const bool gate = u.pn >= 8;
        const int col0 = (u.pn & 7) * 256 + wc * 32 + 8 * fq; bf16_t* O = gate ? SZ : XM;
#pragma unroll
        for (int ai = 0; ai < 2; ++ai)
#pragma unroll
            for (int m = 0; m < 4; ++m) { const int row = row0 + ai * 128 + m * 16; const float s = inv[row]; bf16_t* rowp = O + (size_t)row * 2048 + col0;
#pragma unroll
                for (int bj = 0; bj < 2; ++bj) { f32x4 v0 = acc[ai][bj][m][0] * s, v1 = acc[ai][bj][m][1] * s;
                    if (gate) {
#pragma unroll
                        for (int e = 0; e < 4; ++e) { v0[e] = silu_f(v0[e]); v1[e] = silu_f(v1[e]); } }
                    u32x4 w; w.x = cvt_pk_bf16(v0[0], v0[1]); w.y = cvt_pk_bf16(v0[2], v0[3]); w.z = cvt_pk_bf16(v1[0], v1[1]); w.w = cvt_pk_bf16(v1[2], v1[3]);
                    *(u32x4*)(rowp + bj * 128) = w; } }
    }
};
struct EpiRes {
    static constexpr bool PERM = true, AFTER_DRAIN = false;
    const float* base; float* out; bf16_t* xb; float* ssq;
    __device__ __forceinline__ void operator()(const f32x4 (&acc)[2][2][4][2], const pg8::Unit& u, int wr, int wc, int fr, int fq) const {
        const int row0 = u.pm * 256 + wr * 64 + fr, col0 = u.pn * 256 + wc * 32 + 8 * fq;
#pragma unroll
        for (int ai = 0; ai < 2; ++ai)
#pragma unroll
            for (int m = 0; m < 4; ++m) { const int row = row0 + ai * 128 + m * 16; const size_t off = (size_t)row * 1024 + col0; float ss = 0.f;
#pragma unroll
                for (int bj = 0; bj < 2; ++bj) { const f32x4 b0 = *(const f32x4*)(base + off + bj * 128), b1 = *(const f32x4*)(base + off + bj * 128 + 4);
                    const f32x4 o0 = b0 + acc[ai][bj][m][0], o1 = b1 + acc[ai][bj][m][1];
                    *(f32x4*)(out + off + bj * 128) = o0; *(f32x4*)(out + off + bj * 128 + 4) = o1;
                    ss += (o0[0] * o0[0] + o0[1] * o0[1]) + (o0[2] * o0[2] + o0[3] * o0[3]) + (o1[0] * o1[0] + o1[1] * o1[1]) + (o1[2] * o1[2] + o1[3] * o1[3]);
                    if (xb) { u32x4 w; w.x = cvt_pk_bf16(o0[0], o0[1]); w.y = cvt_pk_bf16(o0[2], o0[3]); w.z = cvt_pk_bf16(o1[0], o1[1]); w.w = cvt_pk_bf16(o1[2], o1[3]);
                        *(u32x4*)(xb + off + bj * 128) = w; } }
                ss += __shfl_xor(ss, 16); ss += __shfl_xor(ss, 32);
                if (fq == 0) ssq[(size_t)row * 16 + u.pn * 4 + wc] = ss;
                asm volatile("" ::: "memory"); }
    }
};
__device__ __forceinline__ float inv_from_ssq(const float* ssq, int row) {
    const f32x4* sp = (const f32x4*)(ssq + (size_t)row * 16); const f32x4 a = sp[0], b = sp[1], c = sp[2], d = sp[3];
    const float s = (((a[0] + a[1]) + (a[2] + a[3])) + ((b[0] + b[1]) + (b[2] + b[3]))) + (((c[0] + c[1]) + (c[2] + c[3])) + ((d[0] + d[1]) + (d[2] + d[3])));
    return 1.0f / sqrtf(s * (1.0f / 1024.0f) + RMS_EPS);
}
struct EpiG3 {
    static constexpr bool PERM = true, AFTER_DRAIN = false;
    const float* ssq; bf16_t* Q; bf16_t* K; bf16_t* SZ;
    __device__ __forceinline__ void operator()(const f32x4 (&acc)[2][2][4][2], const pg8::Unit& u, int wr, int wc, int fr, int fq) const {
        const int row0 = u.pm * 256 + wr * 64 + fr; const bool gate = u.pn >= 8;
        const int colw = wc * 32 + 8 * fq; bf16_t* O; int ldc, col0;
        if (u.pn < 4) { O = Q; ldc = 1024; col0 = u.pn * 256 + colw; } else if (u.pn < 8) { O = K; ldc = 1024; col0 = (u.pn - 4) * 256 + colw; } else { O = SZ; ldc = 2048; col0 = (u.pn - 8) * 256 + colw; }
#pragma unroll
        for (int ai = 0; ai < 2; ++ai)
#pragma unroll
            for (int m = 0; m < 4; ++m) { const int row = row0 + ai * 128 + m * 16; const float s = inv_from_ssq(ssq, row); bf16_t* rowp = O + (size_t)row * ldc + col0;
#pragma unroll
                for (int bj = 0; bj < 2; ++bj) { f32x4 v0 = acc[ai][bj][m][0] * s, v1 = acc[ai][bj][m][1] * s;
                    if (gate) {
#pragma unroll
                        for (int e = 0; e < 4; ++e) { v0[e] = silu_f(v0[e]); v1[e] = silu_f(v1[e]); } }
                    u32x4 w; w.x = cvt_pk_bf16(v0[0], v0[1]); w.y = cvt_pk_bf16(v0[2], v0[3]); w.z = cvt_pk_bf16(v1[0], v1[1]); w.w = cvt_pk_bf16(v1[2], v1[3]);
                    *(u32x4*)(rowp + bj * 128) = w; } }
    }
};
struct EpiVT {
    static constexpr bool PERM = true, AFTER_DRAIN = false;
    const float* ssq; bf16_t* VT;
    __device__ __forceinline__ void operator()(const f32x4 (&acc)[2][2][4][2], const pg8::Unit& u, int wr, int wc, int fr, int fq) const {
        const int row0 = u.pm * 256 + wr * 64 + fr; const int tok0 = u.pn * 256 + wc * 32 + 8 * fq;
        const float myinv = inv_from_ssq(ssq, tok0 + 128 * (fr >> 3) + (fr & 7));
        const int lane = (int)(threadIdx.x & 63);
        float sc[2][8];
#pragma unroll
        for (int bj = 0; bj < 2; ++bj)
#pragma unroll
            for (int e = 0; e < 8; ++e) sc[bj][e] = __shfl(myinv, (lane & 48) | (bj * 8 + e));
        const int b = tok0 >> 11, s0 = tok0 & 2047;
#pragma unroll
        for (int ai = 0; ai < 2; ++ai)
#pragma unroll
            for (int m = 0; m < 4; ++m) { const int row = row0 + ai * 128 + m * 16; bf16_t* rowp = VT + ((size_t)b * 2048 + row) * 2048 + s0;
#pragma unroll
                for (int bj = 0; bj < 2; ++bj) { const f32x4 v0 = acc[ai][bj][m][0], v1 = acc[ai][bj][m][1]; u32x4 w;
                    w.x = cvt_pk_bf16(v0[0] * sc[bj][0], v0[1] * sc[bj][1]); w.y = cvt_pk_bf16(v0[2] * sc[bj][2], v0[3] * sc[bj][3]);
                    w.z = cvt_pk_bf16(v1[0] * sc[bj][4], v1[1] * sc[bj][5]); w.w = cvt_pk_bf16(v1[2] * sc[bj][6], v1[3] * sc[bj][7]);
                    *(u32x4*)(rowp + bj * 128) = w; } }
    }
};

__device__ __forceinline__ void tr_item(const float* W, int ld, int K, bf16_t* WT, int kb, int nsrc0, int ndst0, const float* kscale, float mul, LAS float* scr, int lane) {
    const int k0 = 64 * kb;
#pragma unroll 8
    for (int i = 0; i < 32; ++i) { const int kk = 2 * i + (lane >> 5); float v = W[(size_t)(k0 + kk) * ld + nsrc0 + (lane & 31)]; if (kscale) v *= kscale[k0 + kk]; scr[kk * 33 + (lane & 31)] = v * mul; }
    LDS_WAIT(); asm volatile("" ::: "memory");
    const int c = lane & 7;
#pragma unroll
    for (int j = 0; j < 4; ++j) { const int n = (lane >> 3) + 8 * j; const LAS float* s = scr + (8 * c) * 33 + n;
        u32x4 o; o.x = cvt_pk_bf16(s[0 * 33], s[1 * 33]); o.y = cvt_pk_bf16(s[2 * 33], s[3 * 33]); o.z = cvt_pk_bf16(s[4 * 33], s[5 * 33]); o.w = cvt_pk_bf16(s[6 * 33], s[7 * 33]);
        *(u32x4*)(WT + (size_t)(ndst0 + n) * K + k0 + 8 * c) = o; }
    LDS_WAIT(); asm volatile("" ::: "memory");
}
struct Args { const float* x; const float* norm_g; const float* pool_w_in; const float* pool_w; const float* pool_scale; const float* pool_w_out;
              const float* sb_w_in; const float* sb_w_out; const float* norm_f; float* out; unsigned char* ws; int ph_lo, ph_hi; };

__device__ __forceinline__ void prep_phase(const Args& a, LAS unsigned char* lds, int G, int lane, int wave) {
    unsigned char* ws = a.ws;
    bf16_t* W0T = (bf16_t*)(ws + WS_W0T); bf16_t* W0OT = (bf16_t*)(ws + WS_W0OT); bf16_t* W1T = (bf16_t*)(ws + WS_W1T); bf16_t* W1OT = (bf16_t*)(ws + WS_W1OT);
    bf16_t* FA = (bf16_t*)(ws + WS_FA); bf16_t* FB = (bf16_t*)(ws + WS_FB); float* INV0 = (float*)(ws + WS_INV0); bf16_t* XB = (bf16_t*)(ws + WS_XB);
    LAS float* scr = (LAS float*)(lds + wave * 16384);
    const int gw = blockIdx.x * 8 + wave, NGW = G * 8;
    constexpr int I1 = 16 * 64, I2 = 32 * 32, I3 = 16 * 192, I4 = 32 * 32, I5 = 4 * 8 * 16, NIT = I1 + I2 + I3 + I4 + I5;
    for (int it = gw; it < NIT; it += NGW) {
        int r = it;
        if (r < I1) { const int kb = r / 64, nb = r % 64; tr_item(a.pool_w_in, 4096, 1024, W0T, kb, 2048 + 32 * nb, 2048 + 32 * nb, a.norm_g, 1.f, scr, lane); continue; } r -= I1;
        if (r < I2) { const int kb = r / 32, nb = r % 32; tr_item(a.pool_w_out, 1024, 2048, W0OT, kb, 32 * nb, 32 * nb, nullptr, 1.f, scr, lane); continue; } r -= I2;
        if (r < I3) { const int kb = r / 192, nb = r % 192; const int ns = 32 * nb; const int nd = ns < 2048 ? ns : (ns < 4096 ? ns + 2048 : ns - 2048);
                      tr_item(a.sb_w_in, 6144, 1024, W1T, kb, ns, nd, a.norm_g + 1024, ns < 1024 ? QSCALE : 1.f, scr, lane); continue; } r -= I3;
        if (r < I4) { const int kb = r / 32, nb = r % 32; tr_item(a.sb_w_out, 1024, 2048, W1OT, kb, 32 * nb, 32 * nb, nullptr, 1.f, scr, lane); continue; } r -= I4;
        { const int g = r / 128, q = r % 128, kb = q / 16, nb = q % 16; tr_item(a.pool_w + (size_t)g * 512 * 512, 512, 512, FA, kb, 32 * nb, g * 512 + 32 * nb, nullptr, 1.f, scr, lane); }
    }
    for (int k = gw; k < 1024; k += NGW) { const float gk = a.norm_g[k]; const f32x4* src = (const f32x4*)(a.pool_w_in + (size_t)k * 4096);
#pragma unroll
        for (int j = 0; j < 8; ++j) { const int c = 4 * lane + 256 * j; const f32x4 v = src[lane + 64 * j] * gk; u32x2 w; w.x = cvt_pk_bf16(v[0], v[1]); w.y = cvt_pk_bf16(v[2], v[3]);
            *(u32x2*)(FB + ((size_t)(c >> 9) * 1024 + k) * 512 + (c & 511)) = w; } }
    for (int m = gw; m < MTOK; m += NGW) { const f32x4* xr = (const f32x4*)(a.x + (size_t)m * DM) + lane; f32x4 v[4]; float s = 0.f;
#pragma unroll
        for (int j = 0; j < 4; ++j) { v[j] = xr[64 * j]; s += (v[j][0] * v[j][0] + v[j][1] * v[j][1]) + (v[j][2] * v[j][2] + v[j][3] * v[j][3]); }
        s = wave_sum(s); if (lane == 0) INV0[m] = 1.0f / sqrtf(s * (1.0f / 1024.0f) + RMS_EPS);
        u32x2* o = (u32x2*)(XB + (size_t)m * DM) + lane;
#pragma unroll
        for (int j = 0; j < 4; ++j) { u32x2 w; w.x = cvt_pk_bf16(v[j][0], v[j][1]); w.y = cvt_pk_bf16(v[j][2], v[j][3]); o[64 * j] = w; } }
}

__device__ __forceinline__ void unpack8(const u32x4 w, float (&f)[8]) { f[0] = bf_lo(w.x); f[1] = bf_hi(w.x); f[2] = bf_lo(w.y); f[3] = bf_hi(w.y); f[4] = bf_lo(w.z); f[5] = bf_hi(w.z); f[6] = bf_lo(w.w); f[7] = bf_hi(w.w); }
__device__ __forceinline__ void pool_phase(const bf16_t* XM, const bf16_t* SZ, bf16_t* SZY, const float* scale, int G, int tid) {
    for (int task = blockIdx.x * 512 + tid; task < BATCH * 32 * 256; task += G * 512) {
        const int cc = task & 255, rc = (task >> 8) & 31, b = task >> 13, c0 = cc * 8, w = 2 << (c0 >> 9), ts = rc * 64;
        const size_t base = (size_t)b * SEQ * 2048 + c0;
        float sc[8]; { const f32x4 s0 = *(const f32x4*)(scale + c0), s1 = *(const f32x4*)(scale + c0 + 4); sc[0] = s0[0]; sc[1] = s0[1]; sc[2] = s0[2]; sc[3] = s0[3]; sc[4] = s1[0]; sc[5] = s1[1]; sc[6] = s1[2]; sc[7] = s1[3]; }
        float sum[8];
#pragma unroll
        for (int e = 0; e < 8; ++e) sum[e] = 0.f;
        for (int j = (ts - w + 1 > 0 ? ts - w + 1 : 0); j < ts; ++j) { float f[8]; unpack8(*(const u32x4*)(XM + base + (size_t)j * 2048), f);
#pragma unroll
            for (int e = 0; e < 8; ++e) sum[e] += f[e]; }
#pragma unroll 4
        for (int t = ts; t < ts + 64; ++t) {
            float cur[8], z[8], old[8]; unpack8(*(const u32x4*)(XM + base + (size_t)t * 2048), cur); unpack8(*(const u32x4*)(SZ + base + (size_t)t * 2048), z);
            const int jo = t - w + 1; const bool has_old = jo >= 0;
            unpack8(*(const u32x4*)(XM + base + (size_t)(has_old ? jo : 0) * 2048), old);
            const float rc_ = 1.0f / (float)(t + 1 < w ? t + 1 : w);
            float y[8];
#pragma unroll
            for (int e = 0; e < 8; ++e) { sum[e] += cur[e]; y[e] = (sum[e] * rc_ - cur[e]) * sc[e] * z[e]; sum[e] -= has_old ? old[e] : 0.f; }
            u32x4 o; o.x = cvt_pk_bf16(y[0], y[1]); o.y = cvt_pk_bf16(y[2], y[3]); o.z = cvt_pk_bf16(y[4], y[5]); o.w = cvt_pk_bf16(y[6], y[7]);
            *(u32x4*)(SZY + base + (size_t)t * 2048) = o;
        }
    }
}

__device__ __forceinline__ bf16x8 pack8(const float* a) { u32x4 w; w.x = cvt_pk_bf16(a[0], a[1]); w.y = cvt_pk_bf16(a[2], a[3]); w.z = cvt_pk_bf16(a[4], a[5]); w.w = cvt_pk_bf16(a[6], a[7]); return __builtin_bit_cast(bf16x8, w); }
__device__ __forceinline__ void dma16(const void* g, LAS unsigned char* l) { __builtin_amdgcn_global_load_lds((const unsigned*)g, (LAS unsigned*)l, 16, 0, 0); }
template <int DUMMY> __device__ __forceinline__ void attn_phase(const bf16_t* __restrict__ Q, const bf16_t* __restrict__ Kp, const bf16_t* __restrict__ VT, bf16_t* Y, bf16_t* XBd, LAS unsigned char* lds, int G, int lane, int wave) {
    const int n = lane & 31, hi = lane >> 5;
    const int pmr = (n & 19) | ((n & 4) << 1) | ((n & 8) >> 1);
    LAS unsigned char* wl = lds + wave * 16384;
    const int kd_row = lane >> 3, kd_c0 = ((lane & 7) ^ (lane >> 4)) * 8;
    const size_t kd_off0 = (size_t)kd_row * 1024 + kd_c0, kd_off1 = (size_t)kd_row * 1024 + (kd_c0 ^ 32);
    const size_t vd_off = (size_t)(lane >> 2) * 2048 + ((lane & 3) ^ ((lane >> 4) & 3)) * 8;
    const int kr_base = pmr * 128, kr_sw = (pmr >> 1) & 7;
    const int vr_base = 8192 + n * 64, vr_sw = (n >> 2) & 3;
    constexpr int NU = BATCH * NH * 64;
    const int ustride = G * 8;
    int u = blockIdx.x * 8 + wave;
    bf16x8 qf[4];
    const bf16_t* kg; const bf16_t* vg;
#define ATTN_SETUP(uu) do { const int bh_ = (uu) >> 6, qb_ = (uu) & 63, b_ = bh_ >> 4, h_ = bh_ & 15; \
        const bf16_t* qrow_ = Q + (size_t)(b_ * SEQ + qb_ * 32 + n) * 1024 + h_ * 64 + hi * 8; \
        kg = Kp + (size_t)(b_ * SEQ) * 1024 + h_ * 64; vg = VT + ((size_t)b_ * 2048 + h_ * 128) * 2048; \
        _Pragma("unroll") for (int c = 0; c < 4; ++c) qf[c] = *(const bf16x8*)(qrow_ + 16 * c); \
        const bf16_t* ks_ = kg + (size_t)(qb_ * 32) * 1024; \
        _Pragma("unroll") for (int j = 0; j < 4; ++j) dma16(ks_ + (size_t)(8 * j) * 1024 + ((j & 1) ? kd_off1 : kd_off0), wl + j * 1024); \
        const bf16_t* vs_ = vg + qb_ * 32 + vd_off; \
        _Pragma("unroll") for (int j = 0; j < 8; ++j) dma16(vs_ + (size_t)(16 * j) * 2048, wl + 8192 + j * 1024); } while (0)
    asm volatile("s_waitcnt vmcnt(0) lgkmcnt(0)" ::: "memory");
    if (u < NU) { ATTN_SETUP(u); asm volatile("s_waitcnt vmcnt(0)" ::: "memory"); }
    while (u < NU) {
        const int bh = u >> 6, qb = u & 63, b = bh >> 4, h = bh & 15, t0 = qb * 32, t = t0 + n;
        f32x16 o[4];
#pragma unroll
        for (int blk = 0; blk < 4; ++blk)
#pragma unroll
            for (int e = 0; e < 16; ++e) o[blk][e] = 0.f;
        float carry = 1.f; int kbuf = 0;
        for (int kb = qb; kb >= (DUMMY == 3 ? qb + 1 : 0); --kb) {
            const int key0 = kb * 32, kbn = kb > 0 ? kb - 1 : 0;
            if (kb != qb) asm volatile("s_waitcnt vmcnt(8)" ::: "memory");
            bf16x8 kf[4];
#pragma unroll
            for (int c = 0; c < 4; ++c) kf[c] = *(const LAS bf16x8*)(wl + kbuf * 4096 + kr_base + (((2 * c + hi) ^ kr_sw) * 16));
            {   const bf16_t* ks = kg + (size_t)(kbn * 32) * 1024;
#pragma unroll
                for (int j = 0; j < 4; ++j) dma16(ks + (size_t)(8 * j) * 1024 + ((j & 1) ? kd_off1 : kd_off0), wl + (kbuf ^ 1) * 4096 + j * 1024); }
            f32x16 s;
#pragma unroll
            for (int e = 0; e < 16; ++e) s[e] = 0.f;
#pragma unroll
            for (int c = 0; c < 4; ++c) s = __builtin_amdgcn_mfma_f32_32x32x16_bf16(kf[c], qf[c], s, 0, 0, 0);
            float om[16], be[16], ex[16];
#pragma unroll
            for (int e = 0; e < 16; ++e) { const float r = __builtin_amdgcn_rcpf(1.0f + __builtin_amdgcn_exp2f(s[e])); om[e] = r; be[e] = 1.0f - r; }
            if (kb == qb) {
#pragma unroll
                for (int e = 0; e < 16; ++e) { const int key = key0 + 16 * (e >> 3) + 8 * hi + (e & 7); const bool v = key < t; om[e] = v ? om[e] : 1.f; be[e] = v ? be[e] : 0.f; } }
            float run = 1.f;
#pragma unroll
            for (int e = 7; e >= 0; --e) { ex[e] = run; run *= om[e]; }
            const float pA = run; run = 1.f;
#pragma unroll
            for (int e = 15; e >= 8; --e) { ex[e] = run; run *= om[e]; }
            const float pB = run;
            const float pAo = __shfl_xor(pA, 32), pBo = __shfl_xor(pB, 32);
            const float mB = (hi ? 1.f : pBo) * carry;
            const float mA = (hi ? pB * pBo : pAo * pB * pBo) * carry;
            float av[16];
#pragma unroll
            for (int e = 0; e < 16; ++e) av[e] = be[e] * ex[e] * (e < 8 ? mA : mB);
            carry *= (pA * pAo) * (pB * pBo);
            const bf16x8 pf0 = pack8(av), pf1 = pack8(av + 8);
            if (kb != qb) asm volatile("s_waitcnt vmcnt(4)" ::: "memory");
            bf16x8 vf[4][2];
#pragma unroll
            for (int blk = 0; blk < 4; ++blk)
#pragma unroll
                for (int c = 0; c < 2; ++c) vf[blk][c] = *(const LAS bf16x8*)(wl + vr_base + blk * 2048 + (((2 * c + hi) ^ vr_sw) * 16));
            asm volatile("s_waitcnt lgkmcnt(0)" ::: "memory");
            {   const bf16_t* vs = vg + kbn * 32 + vd_off;
#pragma unroll
                for (int j = 0; j < 8; ++j) dma16(vs + (size_t)(16 * j) * 2048, wl + 8192 + j * 1024); }
#pragma unroll
            for (int blk = 0; blk < 4; ++blk) { o[blk] = __builtin_amdgcn_mfma_f32_32x32x16_bf16(vf[blk][0], pf0, o[blk], 0, 0, 0); o[blk] = __builtin_amdgcn_mfma_f32_32x32x16_bf16(vf[blk][1], pf1, o[blk], 0, 0, 0); }
            kbuf ^= 1;
            if (__all(carry < 1e-30f)) break;
        }
        bf16_t* yrow = Y + (size_t)(b * SEQ + t) * 2048 + h * 128 + 4 * hi;
        asm volatile("s_waitcnt vmcnt(0)" ::: "memory");
        u += ustride;
        if (u < NU) ATTN_SETUP(u);
        if (DUMMY == 2) { float acc_ = 0.f; for (int blk = 0; blk < 4; ++blk) for (int e = 0; e < 16; ++e) acc_ += o[blk][e]; if (acc_ == 123.456f) XBd[lane] = 1; asm volatile("s_waitcnt vmcnt(0)" ::: "memory"); continue; }
        const int er = lane >> 3, ec = lane & 7;
        const bf16_t* ybase = Y + (size_t)(b * SEQ + t0 + er) * 2048 + h * 128 + 8 * ec;
        u32x4 zz[2][4];
#pragma unroll
        for (int half = 0; half < 2; ++half)
#pragma unroll
            for (int k = 0; k < 4; ++k) zz[half][k] = *(const u32x4*)(ybase + (size_t)(8 * k) * 2048 + 64 * half);
        LAS unsigned char* tb = wl + 4096;
#pragma unroll
        for (int half = 0; half < 2; ++half) {
#pragma unroll
            for (int bl = 0; bl < 2; ++bl)
#pragma unroll
                for (int i = 0; i < 4; ++i) { const int blk = 2 * half + bl; u32x2 w; w.x = cvt_pk_bf16(o[blk][4 * i + 0], o[blk][4 * i + 1]); w.y = cvt_pk_bf16(o[blk][4 * i + 2], o[blk][4 * i + 3]);
                    *(LAS u32x2*)(tb + n * 128 + (((4 * bl + i) ^ (n & 7)) * 16) + hi * 8) = w; }
            asm volatile("s_waitcnt lgkmcnt(0)" ::: "memory");
            u32x4 ov[4];
#pragma unroll
            for (int k = 0; k < 4; ++k) ov[k] = *(const LAS u32x4*)(tb + (er + 8 * k) * 128 + ((ec ^ er) * 16));
            asm volatile("s_waitcnt lgkmcnt(0)" ::: "memory");
            if (half == 0) asm volatile("s_waitcnt vmcnt(4)" ::: "memory"); else asm volatile("s_waitcnt vmcnt(0)" ::: "memory");
#pragma unroll
            for (int k = 0; k < 4; ++k) { const u32x4 z = zz[half][k], a_ = ov[k]; u32x4 w;
                w.x = cvt_pk_bf16(bf_lo(a_.x) * bf_lo(z.x), bf_hi(a_.x) * bf_hi(z.x)); w.y = cvt_pk_bf16(bf_lo(a_.y) * bf_lo(z.y), bf_hi(a_.y) * bf_hi(z.y));
                w.z = cvt_pk_bf16(bf_lo(a_.z) * bf_lo(z.z), bf_hi(a_.z) * bf_hi(z.z)); w.w = cvt_pk_bf16(bf_lo(a_.w) * bf_lo(z.w), bf_hi(a_.w) * bf_hi(z.w));
                bf16_t* p = (bf16_t*)ybase + (size_t)(8 * k) * 2048 + 64 * half; if (DUMMY) p = XBd + ((size_t)(p - Y) & (size_t)(32 * 1048576 - 1));
                *(u32x4*)p = w; }
        }
    }
#undef ATTN_SETUP
    asm volatile("s_waitcnt vmcnt(0)" ::: "memory");
}

#define XB_TMO      128
#define XB_XCNT(j)  (256  + 64 * (j))
#define XB_XSUB(j)  (1280 + 64 * (j))
#define XB_XGEN(j)  (2304 + 64 * (j))
#define XB_TOP      3328
#define XB_TOPGEN   3392
#define XCD_BAR_WORDS 3456
#define XB_SPIN_CAP (1u << 18)

__device__ __forceinline__ unsigned xb_ld(unsigned* p)              { return __hip_atomic_load(p, __ATOMIC_RELAXED, __HIP_MEMORY_SCOPE_AGENT); }
__device__ __forceinline__ unsigned xb_add(unsigned* p, unsigned v) { return __hip_atomic_fetch_add(p, v, __ATOMIC_RELAXED, __HIP_MEMORY_SCOPE_AGENT); }
__device__ __forceinline__ unsigned xb_xcc_id() { return (unsigned)__builtin_amdgcn_s_getreg((3 << 11) | 20) & 0xFu; }
#define XB_SPIN(cond, bar) do { unsigned _sp = 0; while (cond) { __builtin_amdgcn_s_sleep(1); \
    if ((++_sp & 255u) == 0u) { if (xb_ld(&(bar)[XB_TMO])) break; if (_sp > XB_SPIN_CAP) { atomicAdd(&(bar)[XB_TMO], 1u); break; } } } } while (0)

struct XcdBarrier {
    unsigned* bar; unsigned x;
    volatile LAS unsigned* st;
};

__device__ __forceinline__ XcdBarrier xcd_barrier_post(unsigned* bar, volatile LAS unsigned* st) {
    XcdBarrier b; b.bar = bar; b.x = xb_xcc_id(); b.st = st;
    if (threadIdx.x == 0) (void)xb_add(&bar[XB_XCNT(b.x)], 1u);
    return b;
}
__device__ __forceinline__ void xcd_barrier_complete(unsigned* bar, unsigned x, unsigned& nloc, unsigned& nx) {
    const unsigned G = gridDim.x * gridDim.y * gridDim.z;
    unsigned sum, cnt, mine, sp = 0u;
    for (;;) {
        sum = 0u; cnt = 0u; mine = 0u;
#pragma unroll
        for (unsigned j = 0; j < 16; ++j) { const unsigned c = xb_ld(&bar[XB_XCNT(j)]); sum += c; cnt += (c > 0u) ? 1u : 0u; mine = (j == x) ? c : mine; }
        if (sum == G) break;
        __builtin_amdgcn_s_sleep(1);
        if ((++sp & 255u) == 0u) { if (xb_ld(&bar[XB_TMO])) break; if (sp > XB_SPIN_CAP) { atomicAdd(&bar[XB_TMO], 1u); break; } }
    }
    nloc = mine > 0u ? mine : 1u; nx = cnt > 0u ? cnt : 1u;
}

__device__ __forceinline__ void xcd_barrier(const XcdBarrier& b) {
    asm volatile("s_waitcnt vmcnt(0)" ::: "memory");
    __syncthreads();
    if (threadIdx.x == 0) {
        unsigned* bar = b.bar;
        __builtin_amdgcn_s_waitcnt(0);
        unsigned nloc = b.st[0], nx = b.st[1];
        if (nloc == 0u) { xcd_barrier_complete(bar, b.x, nloc, nx); b.st[0] = nloc; b.st[1] = nx; }
        const unsigned old = xb_add(&bar[XB_XSUB(b.x)], 1u);
        const unsigned gen = old / nloc;
        if (old + 1u == (gen + 1u) * nloc) {
            __builtin_amdgcn_fence(__ATOMIC_RELEASE, "agent");
            asm volatile("s_waitcnt vmcnt(0)" ::: "memory");
            const unsigned og = xb_add(&bar[XB_TOP], 1u);
            const unsigned tg = og / nx;
            if (og + 1u == (tg + 1u) * nx) xb_add(&bar[XB_TOPGEN], 1u);
            else XB_SPIN(xb_ld(&bar[XB_TOPGEN]) == tg, bar);
            __builtin_amdgcn_fence(__ATOMIC_ACQUIRE, "agent");
            xb_add(&bar[XB_XGEN(b.x)], 1u);
            asm volatile("s_waitcnt vmcnt(0)" ::: "memory");
        } else {
            XB_SPIN(xb_ld(&bar[XB_XGEN(b.x)]) == gen, bar);
            __builtin_amdgcn_fence(__ATOMIC_ACQUIRE, "agent");
            asm volatile("s_waitcnt vmcnt(0)" ::: "memory");
        }
    }
    __syncthreads();
}

__global__ void __launch_bounds__(512, 2) mk_fwd(Args a) {
    extern __shared__ __attribute__((aligned(16))) unsigned char lds_raw[];
    cg::grid_group grid = cg::this_grid();
    LAS unsigned char* lds = (LAS unsigned char*)lds_raw;
    const int tid = threadIdx.x, lane = tid & 63, wave = __builtin_amdgcn_readfirstlane(tid >> 6), G = gridDim.x;
    unsigned char* ws = a.ws;
    bf16_t* W0T = (bf16_t*)(ws + WS_W0T); bf16_t* W0OT = (bf16_t*)(ws + WS_W0OT); bf16_t* W1T = (bf16_t*)(ws + WS_W1T); bf16_t* W1OT = (bf16_t*)(ws + WS_W1OT);
    bf16_t* FA = (bf16_t*)(ws + WS_FA); bf16_t* FB = (bf16_t*)(ws + WS_FB); float* INV0 = (float*)(ws + WS_INV0); float* SSQ1 = (float*)(ws + WS_SSQ1); float* SSQ2 = (float*)(ws + WS_SSQ2);
    bf16_t* XB = (bf16_t*)(ws + WS_XB); bf16_t* RA = (bf16_t*)(ws + WS_A); bf16_t* RB = (bf16_t*)(ws + WS_B); bf16_t* RC = (bf16_t*)(ws + WS_C);
    const int lo = a.ph_lo, hi = a.ph_hi;
    volatile LAS unsigned* MISC = (volatile LAS unsigned*)(lds + MISC_OFF);
    if (tid < 64) MISC[tid] = 0u;
    __syncthreads();
    if (lo < 0) grid.sync();
    const XcdBarrier bar = xcd_barrier_post((unsigned*)(ws + WS_CTL), MISC);
#define IN(k) (lo <= (k) && (k) < hi)
#define SEAM(k) do { if (IN(k) && IN((k) + 1)) xcd_barrier(bar); } while (0)
    constexpr int NOGRP = 30;
    if (MK_PROBE & 256) { for (int i = 0; i < 16; ++i) grid.sync(); }
    if (MK_PROBE & 512) { const int gw = blockIdx.x * 8 + wave, NGW = G * 8; for (int m = gw; m < MTOK; m += NGW) { const float inv = 1.0f + SSQ2[m]; const f32x4* r = (const f32x4*)(a.x + (size_t)m * DM) + lane; f32x4* w = (f32x4*)((float*)RA + (size_t)m * DM) + lane;
        for (int j = 0; j < 4; ++j) w[64 * j] = r[64 * j] * inv; } }
    if (IN(0)) { prep_phase(a, lds, G, lane, wave); __syncthreads(); if (MK_PROBE & 1) { prep_phase(a, lds, G, lane, wave); __syncthreads(); } }
    SEAM(0);
    if (IN(1)) { pg8::Gemm g{FA, FB, 2048, 1024, 512, 1, (size_t)1024 * 512 * 2}; pg8::StaticOrder S; S.init(2048, 1024, G, (int)blockIdx.x);
        EpiStore E{W0T, 1024}; pg8::gemm_phase<EpiStore, pg8::StaticOrder, true, true>(lds, g, S, E); if (MK_PROBE & 2) pg8::gemm_phase<EpiStore, pg8::StaticOrder, true, true>(lds, g, S, E); }
    SEAM(1);
    if (IN(2)) { pg8::Gemm g{XB, W0T, MTOK, 4096, 1024, NOGRP, 0}; pg8::StaticOrder S; S.init(MTOK, 4096, G, (int)blockIdx.x);
        EpiG1 E{INV0, RA, RB}; pg8::gemm_phase<EpiG1, pg8::StaticOrder, true, true>(lds, g, S, E); if (MK_PROBE & 4) pg8::gemm_phase<EpiG1, pg8::StaticOrder, true, true>(lds, g, S, E); }
    SEAM(2);
    if (IN(3)) { if (MK_PROBE & 8) pool_phase(RA, RB, RC, a.pool_scale, G, tid); pool_phase(RA, RB, RB, a.pool_scale, G, tid); }
    SEAM(3);
    if (IN(4)) { pg8::Gemm g{RB, W0OT, MTOK, 1024, 2048, NOGRP, 0}; pg8::StaticOrder S; S.init(MTOK, 1024, G, (int)blockIdx.x);
        EpiRes E{a.x, a.out, XB, SSQ1}; pg8::gemm_phase<EpiRes, pg8::StaticOrder, true, true>(lds, g, S, E); if (MK_PROBE & 16) pg8::gemm_phase<EpiRes, pg8::StaticOrder, true, true>(lds, g, S, E); }
    SEAM(4);
    if (IN(5)) {
        { pg8::Gemm g{XB, W1T, MTOK, 4096, 1024, NOGRP, 0}; pg8::StaticOrder S; S.init(MTOK, 4096, G, (int)blockIdx.x);
          EpiG3 E{SSQ1, RA, RA + (size_t)MTOK * 1024, RC}; pg8::gemm_phase<EpiG3, pg8::StaticOrder, true, true>(lds, g, S, E); if (MK_PROBE & 32) pg8::gemm_phase<EpiG3, pg8::StaticOrder, true, true>(lds, g, S, E); }
        { pg8::Gemm g{W1T + (size_t)4096 * 1024, XB, 2048, MTOK, 1024, NOGRP, 0}; pg8::StaticOrder S; S.init(2048, MTOK, G, (int)blockIdx.x);
          EpiVT E{SSQ1, RB}; pg8::gemm_phase<EpiVT, pg8::StaticOrder, true, true>(lds, g, S, E); if (MK_PROBE & 32) pg8::gemm_phase<EpiVT, pg8::StaticOrder, true, true>(lds, g, S, E); }
    }
    SEAM(5);
    if (IN(6)) { if (MK_PROBE & 1024) attn_phase<2>(RA, RA + (size_t)MTOK * 1024, RB, RC, XB, lds, G, lane, wave); if (MK_PROBE & 2048) attn_phase<3>(RA, RA + (size_t)MTOK * 1024, RB, RC, XB, lds, G, lane, wave); if (MK_PROBE & 64) attn_phase<1>(RA, RA + (size_t)MTOK * 1024, RB, RC, XB, lds, G, lane, wave); attn_phase<0>(RA, RA + (size_t)MTOK * 1024, RB, RC, XB, lds, G, lane, wave); __syncthreads(); }
    SEAM(6);
    if (IN(7)) { pg8::Gemm g{RC, W1OT, MTOK, 1024, 2048, NOGRP, 0}; pg8::StaticOrder S; S.init(MTOK, 1024, G, (int)blockIdx.x);
        if (MK_PROBE & 128) { EpiRes E2{a.x, (float*)RA, nullptr, SSQ2}; pg8::gemm_phase<EpiRes, pg8::StaticOrder, true, true>(lds, g, S, E2); }
        EpiRes E{a.out, a.out, nullptr, SSQ2}; pg8::gemm_phase<EpiRes, pg8::StaticOrder, true, true>(lds, g, S, E); }
    SEAM(7);
    if (IN(8)) { const int gw = blockIdx.x * 8 + wave, NGW = G * 8;
        f32x4 gf[4];
#pragma unroll
        for (int j = 0; j < 4; ++j) gf[j] = ((const f32x4*)a.norm_f)[lane + 64 * j];
        for (int m = gw; m < MTOK; m += NGW) { const float inv = inv_from_ssq(SSQ2, m); f32x4* r = (f32x4*)(a.out + (size_t)m * DM) + lane;
#pragma unroll
            for (int j = 0; j < 4; ++j) r[64 * j] = r[64 * j] * inv * gf[j]; } }
#undef IN
#undef SEAM
}

extern "C" void kernel_launch(void* const* d_in, const int* in_sizes, int n_in, void* d_out, int out_size, void* d_ws, size_t ws_size, hipStream_t stream) {
    static int grid = 0;
    if (grid == 0) {
        if (n_in != 9 || in_sizes[0] != MTOK * DM || out_size != MTOK * DM || ws_size < WS_END) { fprintf(stderr, "kernel_launch: unexpected shapes (n_in %d, in0 %d, out %d, ws %zu)\n", n_in, n_in > 0 ? in_sizes[0] : -1, out_size, ws_size); grid = -1; return; }
        int dev = 0, cus = 0, per_cu = 0;
        (void)hipGetDevice(&dev); (void)hipDeviceGetAttribute(&cus, hipDeviceAttributeMultiprocessorCount, dev);
        if (hipFuncSetAttribute((const void*)mk_fwd, hipFuncAttributeMaxDynamicSharedMemorySize, LDS_BYTES) != hipSuccess) { fprintf(stderr, "kernel_launch: hipFuncSetAttribute failed\n"); grid = -1; return; }
        if (hipOccupancyMaxActiveBlocksPerMultiprocessor(&per_cu, (const void*)mk_fwd, 512, LDS_BYTES) != hipSuccess || per_cu < 1) { fprintf(stderr, "kernel_launch: occupancy query failed (%d)\n", per_cu); (void)hipGetLastError(); per_cu = 1; }
        if (per_cu > 1) per_cu = 1;
        grid = cus * per_cu;
        if (grid <= 0) { grid = -1; return; }
    }
    if (grid < 0) return;
    Args a{};
    a.x = (const float*)d_in[0]; a.norm_g = (const float*)d_in[1]; a.pool_w_in = (const float*)d_in[2]; a.pool_w = (const float*)d_in[3]; a.pool_scale = (const float*)d_in[4];
    a.pool_w_out = (const float*)d_in[5]; a.sb_w_in = (const float*)d_in[6]; a.sb_w_out = (const float*)d_in[7]; a.norm_f = (const float*)d_in[8];
    a.out = (float*)d_out; a.ws = (unsigned char*)d_ws;
    if (hipMemsetAsync((char*)d_ws + WS_CTL, 0, CTL_BYTES, stream) != hipSuccess) { fprintf(stderr, "kernel_launch: memset of the barrier words failed\n"); return; }
#if MK_SPLIT
    for (int p = 0; p < NPHASE; ++p) { a.ph_lo = p; a.ph_hi = p + 1; void* args[] = {&a};
        hipError_t e = hipLaunchCooperativeKernel((const void*)mk_fwd, dim3(grid), dim3(512), args, LDS_BYTES, stream);
        if (e != hipSuccess) { fprintf(stderr, "kernel_launch: cooperative launch (phase %d) failed: %s (grid %d)\n", p, hipGetErrorString(e), grid); break; } }
#else
    a.ph_lo = 0; a.ph_hi = NPHASE; void* args[] = {&a};
    hipError_t e = hipLaunchCooperativeKernel((const void*)mk_fwd, dim3(grid), dim3(512), args, LDS_BYTES, stream);
    if (e != hipSuccess) fprintf(stderr, "kernel_launch: cooperative launch failed: %s (grid %d)\n", hipGetErrorString(e), grid);
#endif
}
```
